# Optimizing an MI355X kernel written in HIP

```python
import math
import jax, jax.numpy as jnp
from jax import lax
import numpy as np

D_MODEL = 1024
BATCH = 2
SEQ = 8192
DEPTH = 2

HEAD_DIM = 64
BLOCK = 128
EPS = 1e-6
NEG = -1e30
A_HEADS = 4
A_QK_DIM = 2 * HEAD_DIM
A_V_DIM = 2 * HEAD_DIM
B_HEADS = 8
B_KV_HEADS = 2
B_HALF_WINDOW = 128
C_PATTERNS = ((128, 1), (512, 4), (2048, 16))
C_HEADS_PER_GROUP = 4
C_HEADS = C_HEADS_PER_GROUP * len(C_PATTERNS)
D_HEADS = 12
D_Q_LORA = 384
D_KV_LORA = 256
D_NOPE = 64
D_ROPE = 32
D_V = 64
ROPE_THETA = 10000.0
NUM_BUCKETS = 32
MAX_DISTANCE = 1024
N_BIAS_HEADS = A_HEADS + B_HEADS
D_FF = -(-8 * D_MODEL // (3 * 256)) * 256
AB_IN = A_HEADS * (2 * A_QK_DIM + A_V_DIM) + (B_HEADS + 2 * B_KV_HEADS) * HEAD_DIM
AB_OUT = A_HEADS * A_V_DIM + B_HEADS * HEAD_DIM
CD_IN = 3 * C_HEADS * HEAD_DIM + D_Q_LORA + D_KV_LORA + D_ROPE
CD_OUT = C_HEADS_PER_GROUP * HEAD_DIM + D_HEADS * D_V

kernel_name = 'hybrid_diff_swa_dilated_mla_encoder'


def rmsnorm(x, g):
    xf = x.astype(jnp.float32)
    y = xf * lax.rsqrt(jnp.mean(xf * xf, axis=-1, keepdims=True) + EPS)
    return (y * g.astype(jnp.float32)).astype(x.dtype)


def t5_bucket(rel):
    nb = NUM_BUCKETS // 2
    max_exact = nb // 2
    ret = jnp.where(rel > 0, nb, 0)
    n = jnp.abs(rel)
    nf = jnp.maximum(n, 1).astype(jnp.float32)
    large = max_exact + (jnp.log(nf / max_exact) / math.log(MAX_DISTANCE / max_exact)
                         * (nb - max_exact)).astype(jnp.int32)
    large = jnp.minimum(large, nb - 1)
    return ret + jnp.where(n < max_exact, n, large)


def heads(t, n):
    B, S, _ = t.shape
    return t.reshape(B, S, n, -1).transpose(0, 2, 1, 3)


def merge_heads(t):
    B, n, S, d = t.shape
    return t.transpose(0, 2, 1, 3).reshape(B, S, n * d)


def rope(t, pos):
    half = D_ROPE // 2
    inv = ROPE_THETA ** (-jnp.arange(half, dtype=jnp.float32) / half)
    ang = pos.astype(jnp.float32)[:, None] * inv[None, :]
    cos, sin = jnp.cos(ang)[:, None, :], jnp.sin(ang)[:, None, :]
    tf = t.astype(jnp.float32)
    t1, t2 = tf[..., :half], tf[..., half:]
    return jnp.concatenate([t1 * cos - t2 * sin, t2 * cos + t1 * sin], axis=-1).astype(t.dtype)


def diff_attention(q1, q2, k1, k2, v, lam, bias_tab):
    B, H, S, d = q1.shape
    scale = d ** -0.5
    kpos = jnp.arange(S)

    def block(b):
        qs = b * BLOCK
        q1b = lax.dynamic_slice_in_dim(q1, qs, BLOCK, axis=2)
        q2b = lax.dynamic_slice_in_dim(q2, qs, BLOCK, axis=2)
        qpos = qs + jnp.arange(BLOCK)
        bias = bias_tab[t5_bucket(kpos[None, :] - qpos[:, None])]
        bias = bias.transpose(2, 0, 1).astype(jnp.float32)
        s1 = jnp.einsum('bhqd,bhkd->bhqk', q1b, k1).astype(jnp.float32) * scale + bias
        s2 = jnp.einsum('bhqd,bhkd->bhqk', q2b, k2).astype(jnp.float32) * scale + bias
        p = jax.nn.softmax(s1, axis=-1) - lam * jax.nn.softmax(s2, axis=-1)
        return jnp.einsum('bhqk,bhkd->bhqd', p.astype(v.dtype), v)

    out = lax.map(block, jnp.arange(S // BLOCK))
    return out.transpose(1, 2, 0, 3, 4).reshape(B, H, S, v.shape[-1])


def dense_attention(q, k, v, scale):
    B, H, S, _ = q.shape

    def block(b):
        qb = lax.dynamic_slice_in_dim(q, b * BLOCK, BLOCK, axis=2)
        s = jnp.einsum('bhqd,bhkd->bhqk', qb, k).astype(jnp.float32) * scale
        p = jax.nn.softmax(s, axis=-1).astype(v.dtype)
        return jnp.einsum('bhqk,bhkd->bhqd', p, v)

    out = lax.map(block, jnp.arange(S // BLOCK))
    return out.transpose(1, 2, 0, 3, 4).reshape(B, H, S, v.shape[-1])


def banded_attention(q, k, v, half_window, bias_tab, dilation, sink=None):
    B, H, L, dq = q.shape
    G = k.shape[1]
    rep = H // G
    dv = v.shape[-1]
    W = half_window
    nb = -(-L // BLOCK)
    Lp = nb * BLOCK
    span = BLOCK + 2 * W
    qp = jnp.pad(q, ((0, 0), (0, 0), (0, Lp - L), (0, 0)))
    kp = jnp.pad(k, ((0, 0), (0, 0), (W, Lp - L + W), (0, 0)))
    vp = jnp.pad(v, ((0, 0), (0, 0), (W, Lp - L + W), (0, 0)))
    idx = jnp.arange(nb)[:, None] * BLOCK + jnp.arange(span)[None, :]
    kb = kp[:, :, idx]
    vb = vp[:, :, idx]
    qb = qp.reshape(B, G, rep, nb, BLOCK, dq)
    s = jnp.einsum('bgrnqd,bgnkd->bgrnqk', qb, kb).astype(jnp.float32) * dq ** -0.5
    rel = jnp.arange(span)[None, :] - W - jnp.arange(BLOCK)[:, None]
    bias = bias_tab[t5_bucket(rel * dilation)].astype(jnp.float32)
    bias = bias.transpose(2, 0, 1).reshape(G, rep, 1, BLOCK, span)
    kpos = idx - W
    valid = ((jnp.abs(rel) <= W)[None]
             & (kpos >= 0)[:, None, :] & (kpos < L)[:, None, :])
    s = jnp.where(valid, s + bias, NEG)
    m = jnp.max(s, axis=-1, keepdims=True)
    if sink is not None:
        sk = sink.astype(jnp.float32).reshape(G, rep, 1, 1, 1)
        m = jnp.maximum(m, sk)
    e = jnp.exp(s - m)
    denom = jnp.sum(e, axis=-1, keepdims=True)
    if sink is not None:
        denom = denom + jnp.exp(sk - m)
    o = jnp.einsum('bgrnqk,bgnkd->bgrnqd', (e / denom).astype(v.dtype), vb)
    lse = (m + jnp.log(denom))[..., 0]
    o = o.reshape(B, H, Lp, dv)[:, :, :L]
    lse = lse.reshape(B, H, Lp)[:, :, :L]
    return o, lse


def dilated_group(q, k, v, window, dilation, bias_tab):
    B, H, S, d = q.shape
    L = S // dilation

    def to_strided(t):
        return t.reshape(B, H, L, dilation, d).transpose(0, 3, 1, 2, 4).reshape(B * dilation, H, L, d)

    o, lse = banded_attention(to_strided(q), to_strided(k), to_strided(v),
                              window // (2 * dilation), bias_tab, dilation)
    o = o.reshape(B, dilation, H, L, d).transpose(0, 2, 3, 1, 4).reshape(B, H, S, d)
    lse = lse.reshape(B, dilation, H, L).transpose(0, 2, 3, 1).reshape(B, H, S)
    return o, lse


def mixer_ab(h, w_in, lam_q1, lam_k1, lam_q2, lam_k2, subln, sink, w_o, bias_table, lambda_init):
    proj = h @ w_in
    o1 = A_HEADS * A_QK_DIM
    o2 = o1 + A_HEADS * A_QK_DIM
    o3 = o2 + A_HEADS * A_V_DIM
    o4 = o3 + B_HEADS * HEAD_DIM
    o5 = o4 + B_KV_HEADS * HEAD_DIM
    qa = heads(proj[..., :o1], A_HEADS)
    ka = heads(proj[..., o1:o2], A_HEADS)
    va = heads(proj[..., o2:o3], A_HEADS)
    lam = (jnp.exp(jnp.sum(lam_q1.astype(jnp.float32) * lam_k1.astype(jnp.float32)))
           - jnp.exp(jnp.sum(lam_q2.astype(jnp.float32) * lam_k2.astype(jnp.float32)))
           + lambda_init)
    oa = diff_attention(qa[..., :HEAD_DIM], qa[..., HEAD_DIM:], ka[..., :HEAD_DIM], ka[..., HEAD_DIM:],
                        va, lam, bias_table[:, :A_HEADS])
    oa = rmsnorm(oa, subln) * (1.0 - lambda_init)
    qb = heads(proj[..., o3:o4], B_HEADS)
    kb = heads(proj[..., o4:o5], B_KV_HEADS)
    vb = heads(proj[..., o5:], B_KV_HEADS)
    ob, _ = banded_attention(qb, kb, vb, B_HALF_WINDOW, bias_table[:, A_HEADS:A_HEADS + B_HEADS], 1, sink)
    return jnp.concatenate([merge_heads(oa), merge_heads(ob)], axis=-1) @ w_o


def mixer_cd(h, w_in, q_norm, w_q_b, kv_norm, w_kv_b, w_o, bias_table, pos):
    B, S, _ = h.shape
    proj = h @ w_in
    cw = C_HEADS * HEAD_DIM
    o1, o2, o3 = cw, 2 * cw, 3 * cw
    o4 = o3 + D_Q_LORA
    o5 = o4 + D_KV_LORA
    qc = heads(proj[..., :o1], C_HEADS)
    kc = heads(proj[..., o1:o2], C_HEADS)
    vc = heads(proj[..., o2:o3], C_HEADS)
    outs, lses = [], []
    for g, (window, dilation) in enumerate(C_PATTERNS):
        sl = slice(g * C_HEADS_PER_GROUP, (g + 1) * C_HEADS_PER_GROUP)
        o_g, lse_g = dilated_group(qc[:, sl], kc[:, sl], vc[:, sl], window, dilation, bias_table[:, sl])
        outs.append(o_g)
        lses.append(lse_g)
    wts = jax.nn.softmax(jnp.stack(lses, axis=0), axis=0)
    oc = jnp.sum(wts[..., None] * jnp.stack(outs, axis=0).astype(jnp.float32), axis=0).astype(h.dtype)
    cq = rmsnorm(proj[..., o3:o4], q_norm)
    q = (cq @ w_q_b).reshape(B, S, D_HEADS, D_NOPE + D_ROPE)
    q_pe = rope(q[..., D_NOPE:], pos)
    ckv = rmsnorm(proj[..., o4:o5], kv_norm)
    kv = (ckv @ w_kv_b).reshape(B, S, D_HEADS, D_NOPE + D_V)
    k_pe = rope(proj[..., o5:].reshape(B, S, 1, D_ROPE), pos)
    qd = jnp.concatenate([q[..., :D_NOPE], q_pe], axis=-1).transpose(0, 2, 1, 3)
    kd = jnp.concatenate([kv[..., :D_NOPE], jnp.broadcast_to(k_pe, (B, S, D_HEADS, D_ROPE))],
                         axis=-1).transpose(0, 2, 1, 3)
    vd = kv[..., D_NOPE:].transpose(0, 2, 1, 3)
    od = dense_attention(qd, kd, vd, (D_NOPE + D_ROPE) ** -0.5)
    return jnp.concatenate([merge_heads(oc), merge_heads(od)], axis=-1) @ w_o


def swiglu(h, w_gate, w_up, w_down):
    return (jax.nn.silu(h @ w_gate) * (h @ w_up)) @ w_down


def setup_inputs(seed: int = 0) -> dict:
    key = jax.random.key(seed)
    ks = jax.random.split(key, 24)
    f = jnp.float32
    ne = (DEPTH + 1) // 2
    no = DEPTH // 2

    def w(k, shape, fan_in):
        return jax.random.normal(k, shape, f) * fan_in ** -0.5

    def gain(k, shape):
        return 1.0 + 0.05 * jax.random.normal(k, shape, f)

    return {
        'x': jax.random.normal(ks[0], (BATCH, SEQ, D_MODEL), f),
        'bias_table': 0.3 * jax.random.normal(ks[1], (NUM_BUCKETS, N_BIAS_HEADS), f),
        'attn_norm': gain(ks[2], (DEPTH, D_MODEL)),
        'ffn_norm': gain(ks[3], (DEPTH, D_MODEL)),
        'final_norm': gain(ks[4], (D_MODEL,)),
        'ab_w_in': w(ks[5], (ne, D_MODEL, AB_IN), D_MODEL),
        'ab_lambda_q1': 0.1 * jax.random.normal(ks[6], (ne, HEAD_DIM), f),
        'ab_lambda_k1': 0.1 * jax.random.normal(ks[7], (ne, HEAD_DIM), f),
        'ab_lambda_q2': 0.1 * jax.random.normal(ks[8], (ne, HEAD_DIM), f),
        'ab_lambda_k2': 0.1 * jax.random.normal(ks[9], (ne, HEAD_DIM), f),
        'ab_subln': gain(ks[10], (ne, A_V_DIM)),
        'ab_sink': 0.5 * jax.random.normal(ks[11], (ne, B_HEADS), f),
        'ab_w_o': w(ks[12], (ne, AB_OUT, D_MODEL), AB_OUT),
        'cd_w_in': w(ks[13], (no, D_MODEL, CD_IN), D_MODEL),
        'cd_q_norm': gain(ks[14], (no, D_Q_LORA)),
        'cd_w_q_b': w(ks[15], (no, D_Q_LORA, D_HEADS * (D_NOPE + D_ROPE)), D_Q_LORA),
        'cd_kv_norm': gain(ks[16], (no, D_KV_LORA)),
        'cd_w_kv_b': w(ks[17], (no, D_KV_LORA, D_HEADS * (D_NOPE + D_V)), D_KV_LORA),
        'cd_w_o': w(ks[18], (no, CD_OUT, D_MODEL), CD_OUT),
        'ffn_w_gate': w(ks[19], (DEPTH, D_MODEL, D_FF), D_MODEL),
        'ffn_w_up': w(ks[20], (DEPTH, D_MODEL, D_FF), D_MODEL),
        'ffn_w_down': w(ks[21], (DEPTH, D_FF, D_MODEL), D_FF),
    }


def reference(x, bias_table, attn_norm, ffn_norm, final_norm, ab_w_in, ab_lambda_q1, ab_lambda_k1,
              ab_lambda_q2, ab_lambda_k2, ab_subln, ab_sink, ab_w_o, cd_w_in, cd_q_norm, cd_w_q_b,
              cd_kv_norm, cd_w_kv_b, cd_w_o, ffn_w_gate, ffn_w_up, ffn_w_down):
    pos = jnp.arange(x.shape[1])
    h = x
    for layer in range(DEPTH):
        j = layer // 2
        hn = rmsnorm(h, attn_norm[layer])
        if layer % 2 == 0:
            lambda_init = 0.8 - 0.6 * math.exp(-0.3 * layer)
            mix = mixer_ab(hn, ab_w_in[j], ab_lambda_q1[j], ab_lambda_k1[j], ab_lambda_q2[j],
                           ab_lambda_k2[j], ab_subln[j], ab_sink[j], ab_w_o[j], bias_table, lambda_init)
        else:
            mix = mixer_cd(hn, cd_w_in[j], cd_q_norm[j], cd_w_q_b[j], cd_kv_norm[j], cd_w_kv_b[j],
                           cd_w_o[j], bias_table, pos)
        h = h + mix
        h = h + swiglu(rmsnorm(h, ffn_norm[layer]), ffn_w_gate[layer], ffn_w_up[layer], ffn_w_down[layer])
    return rmsnorm(h, final_norm)
```

```cpp
#include <hip/hip_runtime.h>
#include <cstdint>
#include <cstdio>

typedef unsigned short bf16_t;
typedef float f32x4 __attribute__((ext_vector_type(4)));
typedef unsigned u32x4 __attribute__((ext_vector_type(4)));
typedef unsigned u32x2 __attribute__((ext_vector_type(2)));

constexpr int BATCH = 2, SEQ = 8192, M = BATCH * SEQ, DM = 1024, DFF = 2816;
constexpr float EPS = 1e-6f, LOG2E = 1.4426950408889634f;
constexpr float C2_64 = 0.125f * LOG2E;
constexpr float C2_96 = 0.10206207261596577f * LOG2E;
constexpr int RBW = 2049;

constexpr size_t MiB = 1u << 20;
constexpr size_t WS_MISCF = 0;
constexpr size_t WS_RB = 64 * 1024;
constexpr size_t WS_ROPE = 256 * 1024;
constexpr size_t WS_LSEC = 1536 * 1024;
constexpr size_t WS_SSH = 3 * MiB;
constexpr size_t WS_SSL = 5 * MiB;
constexpr size_t WS_KPE = 7 * MiB;
constexpr size_t WS_W = 8 * MiB;
constexpr size_t WS_HB = 58 * MiB;
constexpr size_t WS_R = 90 * MiB;
constexpr size_t WS_P0 = WS_R;
constexpr size_t WS_AO0 = WS_R + 72 * MiB;
constexpr size_t WS_ACT = WS_R;
constexpr size_t WS_CQ = WS_R, WS_CK = WS_R + 24 * MiB, WS_CV = WS_R + 48 * MiB;
constexpr size_t WS_LAT = WS_R + 72 * MiB;
constexpr size_t WS_QD = WS_R + 96 * MiB;
constexpr size_t WS_KD = WS_R + 132 * MiB;
constexpr size_t WS_VD = WS_HB;
constexpr size_t WS_AO1 = WS_R + 24 * MiB;
constexpr size_t WO_ABIN = 0;
constexpr size_t WO_ABO = WO_ABIN + (size_t)2304 * 1024;
constexpr size_t WO_CDIN = WO_ABO + (size_t)1024 * 1024;
constexpr size_t WO_QB = WO_CDIN + (size_t)3072 * 1024;
constexpr size_t WO_KVB = WO_QB + (size_t)1280 * 384;
constexpr size_t WO_CDO = WO_KVB + (size_t)1536 * 256;
constexpr size_t WO_GU = WO_CDO + (size_t)1024 * 1024;
constexpr size_t WO_DN = WO_GU + (size_t)2 * 5632 * 1024;
constexpr size_t WO_END = WO_DN + (size_t)2 * 1024 * 2816;
static_assert(WO_END * 2 <= 50 * MiB, "weights fit");

struct Params {
    const float* in[22];
    float* out;
    unsigned char* ws;
};

__device__ __forceinline__ unsigned f2bf(float f) { unsigned u = __builtin_bit_cast(unsigned, f); return (u + 0x7fffu + ((u >> 16) & 1u)) >> 16; }
__device__ __forceinline__ unsigned pk2(float lo, float hi) { return f2bf(lo) | (f2bf(hi) << 16); }
__device__ __forceinline__ float bf2f(unsigned short b) { return __builtin_bit_cast(float, (unsigned)b << 16); }
__device__ __forceinline__ float bflo(unsigned w) { return __builtin_bit_cast(float, w << 16); }
__device__ __forceinline__ float bfhi(unsigned w) { return __builtin_bit_cast(float, w & 0xffff0000u); }
__device__ __forceinline__ void store_bf16x8(bf16_t* p, f32x4 a, f32x4 b) {
    u32x4 w; w.x = pk2(a.x, a.y); w.y = pk2(a.z, a.w); w.z = pk2(b.x, b.y); w.w = pk2(b.z, b.w); *(u32x4*)p = w;
}
__device__ __forceinline__ void store_bf16x4(bf16_t* p, f32x4 a) { u32x2 w; w.x = pk2(a.x, a.y); w.y = pk2(a.z, a.w); *(u32x2*)p = w; }
__device__ __forceinline__ void unpack8(u32x4 w, float* f) {
    f[0] = bflo(w.x); f[1] = bfhi(w.x); f[2] = bflo(w.y); f[3] = bfhi(w.y); f[4] = bflo(w.z); f[5] = bfhi(w.z); f[6] = bflo(w.w); f[7] = bfhi(w.w);
}
__device__ __forceinline__ float wave_sum(float v) {
#pragma unroll
    for (int o = 1; o < 64; o <<= 1) v += __shfl_xor(v, o);
    return v;
}
__device__ __forceinline__ float rnorm_slots(const float* s, int nslots, float invdim) {
    float t = 0.f;
    for (int i = 0; i < nslots; i += 4) { f32x4 v = *(const f32x4*)(s + i); t += (v.x + v.y) + (v.z + v.w); }
    return 1.0f / sqrtf(t * invdim + EPS);
}
__device__ __forceinline__ int pedim(int j) { const int g = j >> 3, i = j & 7; return (i < 4) ? 4 * g + i : 16 + 4 * g + (i - 4); }
__device__ __forceinline__ int t5_bucket(int rel) {
    int ret = rel > 0 ? 16 : 0; int n = rel < 0 ? -rel : rel;
    if (n < 8) return ret + n;
    float nf = (float)n;
    int large = 8 + (int)(logf(nf / 8.0f) / logf(128.0f) * 8.0f);
    if (large > 15) large = 15;
    return ret + large;
}

struct ConvJob { const float* W0; const float* W1; const float* gain; bf16_t* Wt; int K, Nsrc, Nout, kind; };
enum { CK_IDENT = 0, CK_CDIN = 1, CK_QB = 2, CK_GU = 3 };
__device__ __forceinline__ int conv_src(int kind, int n, int& which) {
    which = 0;
    if (kind == CK_IDENT) return n;
    if (kind == CK_CDIN) { if (n < 2944) return n; if (n < 2976) return 2944 + pedim(n - 2944); return -1; }
    if (kind == CK_QB) { if (n >= 1152) return -1; const int g32 = n >> 5, head = g32 / 3, part = g32 % 3; return (part < 2) ? head * 96 + part * 32 + (n & 31) : head * 96 + 64 + pedim(n & 31); }
    { const int tile = n >> 8, w = n & 255; which = (w >= 128); return tile * 128 + (w & 127); }
}
__device__ __forceinline__ ConvJob get_job(const Params& P, int j) {
    bf16_t* W = (bf16_t*)(P.ws + WS_W);
    ConvJob J; J.W1 = nullptr; J.gain = nullptr; J.kind = CK_IDENT;
    switch (j) {
    case 0: J.W0 = P.in[5]; J.gain = P.in[2]; J.Wt = W + WO_ABIN; J.K = 1024; J.Nsrc = 2304; J.Nout = 2304; break;
    case 1: J.W0 = P.in[12]; J.Wt = W + WO_ABO; J.K = 1024; J.Nsrc = 1024; J.Nout = 1024; break;
    case 2: J.W0 = P.in[13]; J.gain = P.in[2] + 1024; J.Wt = W + WO_CDIN; J.K = 1024; J.Nsrc = 2976; J.Nout = 3072; J.kind = CK_CDIN; break;
    case 3: J.W0 = P.in[15]; J.gain = P.in[14]; J.Wt = W + WO_QB; J.K = 384; J.Nsrc = 1152; J.Nout = 1280; J.kind = CK_QB; break;
    case 4: J.W0 = P.in[17]; J.gain = P.in[16]; J.Wt = W + WO_KVB; J.K = 256; J.Nsrc = 1536; J.Nout = 1536; break;
    case 5: J.W0 = P.in[18]; J.Wt = W + WO_CDO; J.K = 1024; J.Nsrc = 1024; J.Nout = 1024; break;
    case 6: case 7: { const int l = j - 6; J.W0 = P.in[19] + (size_t)l * 1024 * 2816; J.W1 = P.in[20] + (size_t)l * 1024 * 2816; J.gain = P.in[3] + l * 1024;
        J.Wt = W + WO_GU + (size_t)l * 5632 * 1024; J.K = 1024; J.Nsrc = 2816; J.Nout = 5632; J.kind = CK_GU; break; }
    default: { const int l = j - 8; J.W0 = P.in[21] + (size_t)l * 2816 * 1024; J.Wt = W + WO_DN + (size_t)l * 1024 * 2816; J.K = 2816; J.Nsrc = 1024; J.Nout = 1024; break; }
    }
    return J;
}
__device__ __forceinline__ int job_items(const ConvJob& J) { return (J.K / 64) * (J.Nout / 32); }
__device__ __forceinline__ void conv_item(const ConvJob& J, float* scr, int item, int lane) {
    const int nblk = J.Nout / 32, kb = item / nblk, nb = item % nblk, k0 = 64 * kb, n0 = 32 * nb;
    int which; const int src = conv_src(J.kind, n0 + (lane & 31), which);
    const float* W = J.W0; if (J.kind == CK_GU && (n0 & 255) >= 128) W = J.W1;
#pragma unroll 8
    for (int i = 0; i < 32; ++i) { const int kk = 2 * i + (lane >> 5); const float g = J.gain ? J.gain[k0 + kk] : 1.0f;
        scr[kk * 33 + (lane & 31)] = (src >= 0) ? W[(size_t)(k0 + kk) * J.Nsrc + src] * g : 0.0f; }
    __builtin_amdgcn_s_waitcnt(0xc07f); asm volatile("" ::: "memory");
    const int c = lane & 7;
#pragma unroll
    for (int j = 0; j < 4; ++j) { const int n = (lane >> 3) + 8 * j; const float* s = scr + (8 * c) * 33 + n;
        u32x4 o; o.x = pk2(s[0 * 33], s[1 * 33]); o.y = pk2(s[2 * 33], s[3 * 33]); o.z = pk2(s[4 * 33], s[5 * 33]); o.w = pk2(s[6 * 33], s[7 * 33]);
        *(u32x4*)(J.Wt + (size_t)(n0 + n) * J.K + k0 + 8 * c) = o; }
    __builtin_amdgcn_s_waitcnt(0xc07f); asm volatile("" ::: "memory");
}
__device__ __forceinline__ void prologue_phase(const Params& P, float* scr, int gw, int ngw, int lane) {
    int base = 0;
#define CONV_JOB(j) { const ConvJob J = get_job(P, j); const int n = job_items(J); int first = (gw - base) % ngw; if (first < 0) first += ngw; \
        for (int it = first; it < n; it += ngw) conv_item(J, scr, it, lane); base += n; }
    CONV_JOB(0) CONV_JOB(1) CONV_JOB(2) CONV_JOB(3) CONV_JOB(4) CONV_JOB(5) CONV_JOB(6) CONV_JOB(7) CONV_JOB(8) CONV_JOB(9)
#undef CONV_JOB
    {
        bf16_t* HB = (bf16_t*)(P.ws + WS_HB); float* ssh = (float*)(P.ws + WS_SSH); const float* x = P.in[0];
        for (int m = gw; m < M; m += ngw) {
            const f32x4* xr = (const f32x4*)(x + (size_t)m * DM) + lane; float s = 0.f; f32x4 v[4];
#pragma unroll
            for (int j = 0; j < 4; ++j) { v[j] = xr[64 * j]; s += (v[j].x * v[j].x + v[j].y * v[j].y) + (v[j].z * v[j].z + v[j].w * v[j].w); }
            s = wave_sum(s);
#pragma unroll
            for (int j = 0; j < 4; ++j) store_bf16x4(HB + (size_t)m * DM + 256 * j + 4 * lane, v[j]);
            if (lane < 32) ssh[(size_t)m * 32 + lane] = (lane == 0) ? s : 0.f;
        }
    }
    const int gt = gw * 64 + lane, ngt = ngw * 64;
    {
        float* RB = (float*)(P.ws + WS_RB); const float* tab = P.in[1];
        for (int i = gt; i < 12 * RBW; i += ngt) { const int h = i / RBW, rel = i % RBW - 1024; RB[i] = tab[t5_bucket(rel) * 12 + h] * LOG2E; }
        float* rope = (float*)(P.ws + WS_ROPE);
        for (int i = gt; i < SEQ * 16; i += ngt) { const int pos = i >> 4, d = i & 15;
            const float inv = powf(10000.0f, -(float)d / 16.0f); const float ang = (float)pos * inv;
            double rev = (double)ang * 0.15915494309189535; rev -= rint(rev); const float fr = (float)rev;
            rope[2 * i] = __builtin_amdgcn_cosf(fr); rope[2 * i + 1] = __builtin_amdgcn_sinf(fr); }
        if (gt == 0) { float a = 0.f, b = 0.f; for (int i = 0; i < 64; ++i) { a += P.in[6][i] * P.in[7][i]; b += P.in[8][i] * P.in[9][i]; }
            ((float*)(P.ws + WS_MISCF))[0] = expf(a) - expf(b) + 0.2f; }
    }
}

struct EpiProj0 {
    const float* ssh; bf16_t* P0;
    static constexpr bool SLOTS = false, PAIR = false;
    __device__ __forceinline__ int brow(int c) const { return c; }
    __device__ __forceinline__ int browp(int c) const { return c; }
    __device__ __forceinline__ float rowctx(int row) const { return rnorm_slots(ssh + (size_t)row * 32, 32, 1.0f / 1024.0f); }
    __device__ __forceinline__ float store8(int row, int col0, float rc, f32x4 a, f32x4 b, f32x4, f32x4) const {
        const float sc = rc * ((col0 < 512 || (col0 >= 1536 && col0 < 2048)) ? C2_64 : 1.0f);
        store_bf16x8(P0 + (size_t)row * 2304 + col0, a * sc, b * sc); return 0.f;
    }
    __device__ __forceinline__ void slot(int, int, float) const {}
};
struct EpiResid {
    const float* Hin; float* Hout; bf16_t* HB; float* ssh;
    static constexpr bool SLOTS = true, PAIR = false;
    __device__ __forceinline__ int brow(int c) const { return c; }
    __device__ __forceinline__ int browp(int c) const { return c; }
    __device__ __forceinline__ float rowctx(int) const { return 1.0f; }
    __device__ __forceinline__ float store8(int row, int col0, float, f32x4 a, f32x4 b, f32x4, f32x4) const {
        const size_t o = (size_t)row * DM + col0;
        const f32x4 h0 = *(const f32x4*)(Hin + o) + a, h1 = *(const f32x4*)(Hin + o + 4) + b;
        *(f32x4*)(Hout + o) = h0; *(f32x4*)(Hout + o + 4) = h1; store_bf16x8(HB + o, h0, h1);
        return (h0.x * h0.x + h0.y * h0.y) + (h0.z * h0.z + h0.w * h0.w) + (h1.x * h1.x + h1.y * h1.y) + (h1.z * h1.z + h1.w * h1.w);
    }
    __device__ __forceinline__ void slot(int row, int s, float v) const { ssh[(size_t)row * 32 + s] = v; }
};
__device__ __forceinline__ float silu_mul(float g, float u) { const float e = __builtin_amdgcn_exp2f(-g * LOG2E); return g * __builtin_amdgcn_rcpf(1.0f + e) * u; }
struct EpiSwiGLU {
    const float* ssh; bf16_t* ACT;
    static constexpr bool SLOTS = false, PAIR = true;
    __device__ __forceinline__ int brow(int c) const { return (c >> 7) * 256 + (c & 127); }
    __device__ __forceinline__ int browp(int c) const { return brow(c) + 128; }
    __device__ __forceinline__ float rowctx(int row) const { return rnorm_slots(ssh + (size_t)row * 32, 32, 1.0f / 1024.0f); }
    __device__ __forceinline__ float store8(int row, int col0, float rc, f32x4 a, f32x4 b, f32x4 pa, f32x4 pb) const {
        a = a * rc; b = b * rc; pa = pa * rc; pb = pb * rc; f32x4 o0, o1;
        o0.x = silu_mul(a.x, pa.x); o0.y = silu_mul(a.y, pa.y); o0.z = silu_mul(a.z, pa.z); o0.w = silu_mul(a.w, pa.w);
        o1.x = silu_mul(b.x, pb.x); o1.y = silu_mul(b.y, pb.y); o1.z = silu_mul(b.z, pb.z); o1.w = silu_mul(b.w, pb.w);
        store_bf16x8(ACT + (size_t)row * DFF + col0, o0, o1); return 0.f;
    }
    __device__ __forceinline__ void slot(int, int, float) const {}
};
__device__ __forceinline__ void rope4(const float* rope, int pos, int grp, f32x4 a, f32x4 b, f32x4& o1, f32x4& o2) {
    const f32x4* r = (const f32x4*)(rope + ((size_t)pos * 16 + 4 * grp) * 2);
    const f32x4 r0 = r[0], r1 = r[1];
    o1.x = a.x * r0.x - b.x * r0.y; o2.x = b.x * r0.x + a.x * r0.y;
    o1.y = a.y * r0.z - b.y * r0.w; o2.y = b.y * r0.z + a.y * r0.w;
    o1.z = a.z * r1.x - b.z * r1.y; o2.z = b.z * r1.x + a.z * r1.y;
    o1.w = a.w * r1.z - b.w * r1.w; o2.w = b.w * r1.z + a.w * r1.w;
}
struct EpiProj1 {
    const float* ssh; float* ssl; const float* rope; bf16_t *CQ, *CK, *CV, *LAT, *KPE;
    static constexpr bool SLOTS = true, PAIR = false;
    __device__ __forceinline__ int brow(int c) const { return c; }
    __device__ __forceinline__ int browp(int c) const { return c; }
    __device__ __forceinline__ float rowctx(int row) const { return rnorm_slots(ssh + (size_t)row * 32, 32, 1.0f / 1024.0f); }
    __device__ __forceinline__ float store8(int row, int col0, float rc, f32x4 a, f32x4 b, f32x4, f32x4) const {
        a = a * rc; b = b * rc;
        if (col0 < 768) { store_bf16x8(CQ + (size_t)row * 768 + col0, a * C2_64, b * C2_64); return 0.f; }
        if (col0 < 1536) { store_bf16x8(CK + (size_t)row * 768 + (col0 - 768), a, b); return 0.f; }
        if (col0 < 2304) { store_bf16x8(CV + (size_t)row * 768 + (col0 - 1536), a, b); return 0.f; }
        const int c = col0 - 2304;
        if (c < 640) { store_bf16x8(LAT + (size_t)row * 768 + c, a, b);
            return (a.x * a.x + a.y * a.y) + (a.z * a.z + a.w * a.w) + (b.x * b.x + b.y * b.y) + (b.z * b.z + b.w * b.w); }
        if (c < 672) { const int grp = (c - 640) >> 3; f32x4 o1, o2; rope4(rope, row & (SEQ - 1), grp, a, b, o1, o2);
            store_bf16x4(KPE + (size_t)row * 32 + 4 * grp, o1); store_bf16x4(KPE + (size_t)row * 32 + 16 + 4 * grp, o2); }
        return 0.f;
    }
    __device__ __forceinline__ void slot(int row, int s, float v) const { if (s >= 72 && s < 92) ssl[(size_t)row * 32 + (s - 72)] = v; }
};
struct EpiQb {
    const float* ssl; const float* rope; bf16_t* QD;
    static constexpr bool SLOTS = false, PAIR = false;
    __device__ __forceinline__ int brow(int c) const { return c; }
    __device__ __forceinline__ int browp(int c) const { return c; }
    __device__ __forceinline__ float rowctx(int row) const { return rnorm_slots(ssl + (size_t)row * 32, 12, 1.0f / 384.0f); }
    __device__ __forceinline__ float store8(int row, int col0, float rc, f32x4 a, f32x4 b, f32x4, f32x4) const {
        if (col0 >= 1152) return 0.f;
        const float sc = rc * C2_96; a = a * sc; b = b * sc;
        const int g32 = col0 >> 5, head = g32 / 3, part = g32 % 3;
        bf16_t* q = QD + (size_t)row * 1152 + head * 96;
        if (part < 2) { store_bf16x8(q + part * 32 + (col0 & 31), a, b); return 0.f; }
        const int grp = (col0 & 31) >> 3; f32x4 o1, o2; rope4(rope, row & (SEQ - 1), grp, a, b, o1, o2);
        store_bf16x4(q + 64 + 4 * grp, o1); store_bf16x4(q + 80 + 4 * grp, o2); return 0.f;
    }
    __device__ __forceinline__ void slot(int, int, float) const {}
};
struct EpiKVb {
    const float* ssl; bf16_t *KD, *VD;
    static constexpr bool SLOTS = false, PAIR = false;
    __device__ __forceinline__ int brow(int c) const { return c; }
    __device__ __forceinline__ int browp(int c) const { return c; }
    __device__ __forceinline__ float rowctx(int row) const { return rnorm_slots(ssl + (size_t)row * 32 + 12, 8, 1.0f / 256.0f); }
    __device__ __forceinline__ float store8(int row, int col0, float rc, f32x4 a, f32x4 b, f32x4, f32x4) const {
        a = a * rc; b = b * rc; const int head = col0 >> 7, w = col0 & 127;
        if (w < 64) store_bf16x8(KD + (size_t)row * 768 + head * 64 + w, a, b); else store_bf16x8(VD + (size_t)row * 768 + head * 64 + (w - 64), a, b);
        return 0.f;
    }
    __device__ __forceinline__ void slot(int, int, float) const {}
};

template <class Epi>
__global__ void __launch_bounds__(256) naive_gemm(const bf16_t* A, int lda, const bf16_t* Bt, int K, Epi E) {
    __shared__ float As[256 * 33];
    __shared__ float Bs[2][32 * 36];
    const int tid = threadIdx.x, cg = tid & 3, rg = tid >> 2;
    const int c0 = blockIdx.x * 32, r0 = blockIdx.y * 256, col0 = c0 + cg * 8;
    float acc[4][8], accp[4][8];
#pragma unroll
    for (int i = 0; i < 4; ++i)
#pragma unroll
        for (int j = 0; j < 8; ++j) { acc[i][j] = 0.f; accp[i][j] = 0.f; }
    for (int k0 = 0; k0 < K; k0 += 32) {
        {
            const u32x4* ap = (const u32x4*)(A + (size_t)(r0 + tid) * lda + k0);
#pragma unroll
            for (int q = 0; q < 4; ++q) { float f[8]; unpack8(ap[q], f);
#pragma unroll
                for (int e = 0; e < 8; ++e) As[tid * 33 + q * 8 + e] = f[e]; }
        }
        {
            const int pr = tid >> 7, t = tid & 127, c = t >> 2, q = t & 3;
            if (pr == 0 || Epi::PAIR) {
                const int br = pr ? E.browp(c0 + c) : E.brow(c0 + c);
                float f[8]; unpack8(*(const u32x4*)(Bt + (size_t)br * K + k0 + q * 8), f);
#pragma unroll
                for (int e = 0; e < 8; ++e) Bs[pr][(q * 8 + e) * 36 + c] = f[e];
            }
        }
        __syncthreads();
#pragma unroll 4
        for (int k = 0; k < 32; ++k) {
            float a[4];
#pragma unroll
            for (int i = 0; i < 4; ++i) a[i] = As[(rg + 64 * i) * 33 + k];
            const f32x4 b0 = *(const f32x4*)&Bs[0][k * 36 + cg * 8], b1 = *(const f32x4*)&Bs[0][k * 36 + cg * 8 + 4];
            const float bb[8] = {b0.x, b0.y, b0.z, b0.w, b1.x, b1.y, b1.z, b1.w};
#pragma unroll
            for (int i = 0; i < 4; ++i)
#pragma unroll
                for (int j = 0; j < 8; ++j) acc[i][j] += a[i] * bb[j];
            if (Epi::PAIR) {
                const f32x4 p0 = *(const f32x4*)&Bs[1][k * 36 + cg * 8], p1 = *(const f32x4*)&Bs[1][k * 36 + cg * 8 + 4];
                const float pp[8] = {p0.x, p0.y, p0.z, p0.w, p1.x, p1.y, p1.z, p1.w};
#pragma unroll
                for (int i = 0; i < 4; ++i)
#pragma unroll
                    for (int j = 0; j < 8; ++j) accp[i][j] += a[i] * pp[j];
            }
        }
        __syncthreads();
    }
#pragma unroll
    for (int i = 0; i < 4; ++i) {
        const int row = r0 + rg + 64 * i; const float rc = E.rowctx(row);
        float ss = E.store8(row, col0, rc, (f32x4){acc[i][0], acc[i][1], acc[i][2], acc[i][3]}, (f32x4){acc[i][4], acc[i][5], acc[i][6], acc[i][7]},
                            (f32x4){accp[i][0], accp[i][1], accp[i][2], accp[i][3]}, (f32x4){accp[i][4], accp[i][5], accp[i][6], accp[i][7]});
        if (Epi::SLOTS) { ss += __shfl_xor(ss, 1); ss += __shfl_xor(ss, 2); if (cg == 0) E.slot(row, col0 >> 5, ss); }
    }
}

template <int DQK, bool BIAS>
__device__ __forceinline__ void naive_dense_block(const bf16_t* Q, int qpitch, const bf16_t* K1, int k1pitch, const bf16_t* K2, int k2pitch,
                                                  const bf16_t* V, int vpitch, const float* RBh, int qpos0, float* outF, int opF, bf16_t* outB, int opB) {
    __shared__ float Ks[16 * DQK];
    __shared__ float Vs[16 * 64];
    const int tid = threadIdx.x;
    float q[DQK], o[64];
    {
        const bf16_t* qp = Q + (size_t)tid * qpitch;
#pragma unroll
        for (int c = 0; c < DQK / 8; ++c) unpack8(*(const u32x4*)(qp + c * 8), q + c * 8);
    }
#pragma unroll
    for (int d = 0; d < 64; ++d) o[d] = 0.f;
    float m = -1e30f, l = 0.f;
    const int qpos = qpos0 + tid;
    constexpr int NCH = 16 * (DQK / 8) + 16 * 8;
    for (int kt = 0; kt < SEQ; kt += 16) {
        for (int c = tid; c < NCH; c += 256) {
            if (c < 16 * (DQK / 8)) { const int key = c / (DQK / 8), ch = c % (DQK / 8);
                const bf16_t* src = (ch < 8) ? K1 + (size_t)(kt + key) * k1pitch + ch * 8 : K2 + (size_t)(kt + key) * k2pitch + (ch - 8) * 8;
                float f[8]; unpack8(*(const u32x4*)src, f);
#pragma unroll
                for (int e = 0; e < 8; ++e) Ks[key * DQK + ch * 8 + e] = f[e];
            } else { const int c2 = c - 16 * (DQK / 8), key = c2 >> 3, ch = c2 & 7;
                float f[8]; unpack8(*(const u32x4*)(V + (size_t)(kt + key) * vpitch + ch * 8), f);
#pragma unroll
                for (int e = 0; e < 8; ++e) Vs[key * 64 + ch * 8 + e] = f[e];
            }
        }
        __syncthreads();
        float s[16]; float tmax = -1e30f;
#pragma unroll
        for (int j = 0; j < 16; ++j) {
            float a = 0.f;
#pragma unroll
            for (int d = 0; d < DQK; d += 4) { const f32x4 kv = *(const f32x4*)&Ks[j * DQK + d]; a += q[d] * kv.x + q[d + 1] * kv.y + q[d + 2] * kv.z + q[d + 3] * kv.w; }
            if (BIAS) { int rel = kt + j - qpos; rel = rel < -1024 ? -1024 : (rel > 1024 ? 1024 : rel); a += RBh[rel + 1024]; }
            s[j] = a; tmax = fmaxf(tmax, a);
        }
        const float mn = fmaxf(m, tmax), alpha = __builtin_amdgcn_exp2f(m - mn);
        m = mn; l *= alpha;
#pragma unroll
        for (int d = 0; d < 64; ++d) o[d] *= alpha;
#pragma unroll
        for (int j = 0; j < 16; ++j) {
            const float p = __builtin_amdgcn_exp2f(s[j] - mn); l += p;
#pragma unroll
            for (int d = 0; d < 64; d += 4) { const f32x4 vv = *(const f32x4*)&Vs[j * 64 + d]; o[d] += p * vv.x; o[d + 1] += p * vv.y; o[d + 2] += p * vv.z; o[d + 3] += p * vv.w; }
        }
        __syncthreads();
    }
    const float il = 1.0f / l;
    if (outF) { float* op = outF + (size_t)tid * opF;
#pragma unroll
        for (int d = 0; d < 64; d += 4) *(f32x4*)(op + d) = (f32x4){o[d] * il, o[d + 1] * il, o[d + 2] * il, o[d + 3] * il}; }
    else { bf16_t* op = outB + (size_t)tid * opB;
#pragma unroll
        for (int d = 0; d < 64; d += 8) store_bf16x8(op + d, (f32x4){o[d] * il, o[d + 1] * il, o[d + 2] * il, o[d + 3] * il}, (f32x4){o[d + 4] * il, o[d + 5] * il, o[d + 6] * il, o[d + 7] * il}); }
}
__global__ void __launch_bounds__(256) naive_attn_A(Params P) {
    const int qb = blockIdx.x, y = blockIdx.y, b = y >> 4, h = (y >> 2) & 3, sm = (y >> 1) & 1, vh = y & 1;
    const bf16_t* P0 = (const bf16_t*)(P.ws + WS_P0);
    const size_t row0 = (size_t)b * SEQ;
    naive_dense_block<64, true>(P0 + (row0 + qb * 256) * 2304 + h * 128 + sm * 64, 2304,
                                P0 + row0 * 2304 + 512 + h * 128 + sm * 64, 2304, nullptr, 0,
                                P0 + row0 * 2304 + 1024 + h * 128 + vh * 64, 2304,
                                (const float*)(P.ws + WS_RB) + h * RBW, qb * 256,
                                P.out + (size_t)sm * M * 512 + (row0 + qb * 256) * 512 + h * 128 + vh * 64, 512, nullptr, 0);
}
__global__ void __launch_bounds__(256) naive_attn_D(Params P) {
    const int qb = blockIdx.x, y = blockIdx.y, b = y / 12, h = y % 12;
    const size_t row0 = (size_t)b * SEQ;
    naive_dense_block<96, false>((const bf16_t*)(P.ws + WS_QD) + (row0 + qb * 256) * 1152 + h * 96, 1152,
                                 (const bf16_t*)(P.ws + WS_KD) + row0 * 768 + h * 64, 768, (const bf16_t*)(P.ws + WS_KPE) + row0 * 32, 32,
                                 (const bf16_t*)(P.ws + WS_VD) + row0 * 768 + h * 64, 768, nullptr, qb * 256,
                                 nullptr, 0, (bf16_t*)(P.ws + WS_AO1) + (row0 + qb * 256) * 1024 + 256 + h * 64, 1024);
}
__global__ void __launch_bounds__(256) combine_A(Params P) {
    const int gw = (blockIdx.x * 256 + threadIdx.x) >> 6, lane = threadIdx.x & 63;
    if (gw >= M * 4) return;
    const int row = gw >> 2, h = gw & 3;
    const float lam = ((const float*)(P.ws + WS_MISCF))[0];
    const float* o1 = P.out + (size_t)row * 512 + h * 128 + 2 * lane; const float* o2 = o1 + (size_t)M * 512;
    const float x0 = o1[0] - lam * o2[0], x1 = o1[1] - lam * o2[1];
    const float ss = wave_sum(x0 * x0 + x1 * x1), r = 1.0f / sqrtf(ss * (1.0f / 128.0f) + EPS);
    const float* g = P.in[10];
    bf16_t* ao = (bf16_t*)(P.ws + WS_AO0) + (size_t)row * 1024 + h * 128 + 2 * lane;
    *(unsigned*)ao = pk2(x0 * r * g[2 * lane] * 0.8f, x1 * r * g[2 * lane + 1] * 0.8f);
}

template <int MODE>
__global__ void __launch_bounds__(256) naive_banded(Params P, int grp, int dil) {
    const int p = blockIdx.x * 256 + threadIdx.x, y = blockIdx.y;
    int b, hh, W, bcol; const bf16_t *Q, *K, *V; int pitch;
    if (MODE == 0) { b = y >> 3; hh = y & 7; W = 128; bcol = 4 + hh; pitch = 2304;
        const bf16_t* P0 = (const bf16_t*)(P.ws + WS_P0) + (size_t)b * SEQ * 2304;
        Q = P0 + 1536 + hh * 64; K = P0 + 2048 + (hh >> 2) * 64; V = P0 + 2176 + (hh >> 2) * 64; }
    else { b = y >> 2; hh = grp * 4 + (y & 3); W = 64; bcol = hh; pitch = 768;
        Q = (const bf16_t*)(P.ws + WS_CQ) + (size_t)b * SEQ * 768 + hh * 64; K = (const bf16_t*)(P.ws + WS_CK) + (size_t)b * SEQ * 768 + hh * 64; V = (const bf16_t*)(P.ws + WS_CV) + (size_t)b * SEQ * 768 + hh * 64; }
    const float* RBh = (const float*)(P.ws + WS_RB) + bcol * RBW;
    float q[64], o[64];
#pragma unroll
    for (int c = 0; c < 8; ++c) unpack8(*(const u32x4*)(Q + (size_t)p * pitch + c * 8), q + c * 8);
#pragma unroll
    for (int d = 0; d < 64; ++d) o[d] = 0.f;
    float m = -1e30f, l = 0.f;
    if (MODE == 0) { m = P.in[11][hh] * LOG2E; l = 1.0f; }
    for (int mm = -W; mm <= W; ++mm) {
        const int kp = p + mm * dil;
        if (kp < 0 || kp >= SEQ) continue;
        float kf[8], a = 0.f;
#pragma unroll
        for (int c = 0; c < 8; ++c) { unpack8(*(const u32x4*)(K + (size_t)kp * pitch + c * 8), kf);
#pragma unroll
            for (int e = 0; e < 8; ++e) a += q[c * 8 + e] * kf[e]; }
        a += RBh[mm * dil + 1024];
        const float mn = fmaxf(m, a), alpha = __builtin_amdgcn_exp2f(m - mn), pe = __builtin_amdgcn_exp2f(a - mn);
        m = mn; l = l * alpha + pe;
#pragma unroll
        for (int c = 0; c < 8; ++c) { unpack8(*(const u32x4*)(V + (size_t)kp * pitch + c * 8), kf);
#pragma unroll
            for (int e = 0; e < 8; ++e) o[c * 8 + e] = o[c * 8 + e] * alpha + pe * kf[e]; }
    }
    const float il = 1.0f / l; const size_t row = (size_t)b * SEQ + p;
    bf16_t* op;
    if (MODE == 0) op = (bf16_t*)(P.ws + WS_AO0) + row * 1024 + 512 + hh * 64;
    else { op = (bf16_t*)(P.ws + WS_CQ) + row * 768 + hh * 64; ((float*)(P.ws + WS_LSEC))[((size_t)grp * M + row) * 4 + (y & 3)] = m + __builtin_amdgcn_logf(l); }
#pragma unroll
    for (int d = 0; d < 64; d += 8) store_bf16x8(op + d, (f32x4){o[d] * il, o[d + 1] * il, o[d + 2] * il, o[d + 3] * il}, (f32x4){o[d + 4] * il, o[d + 5] * il, o[d + 6] * il, o[d + 7] * il});
}
__global__ void __launch_bounds__(256) combine_C(Params P) {
    const int t = blockIdx.x * 256 + threadIdx.x; if (t >= M * 32) return;
    const int row = t >> 5, i = (t >> 3) & 3, ch = t & 7;
    const float* lse = (const float*)(P.ws + WS_LSEC);
    const float l0 = lse[((size_t)0 * M + row) * 4 + i], l1 = lse[((size_t)1 * M + row) * 4 + i], l2 = lse[((size_t)2 * M + row) * 4 + i];
    const float mx = fmaxf(l0, fmaxf(l1, l2));
    float w0 = __builtin_amdgcn_exp2f(l0 - mx), w1 = __builtin_amdgcn_exp2f(l1 - mx), w2 = __builtin_amdgcn_exp2f(l2 - mx);
    const float inv = 1.0f / (w0 + w1 + w2); w0 *= inv; w1 *= inv; w2 *= inv;
    const bf16_t* cq = (const bf16_t*)(P.ws + WS_CQ) + (size_t)row * 768 + i * 64 + ch * 8;
    float a[8], bb[8], c[8]; unpack8(*(const u32x4*)cq, a); unpack8(*(const u32x4*)(cq + 256), bb); unpack8(*(const u32x4*)(cq + 512), c);
    float r[8];
#pragma unroll
    for (int e = 0; e < 8; ++e) r[e] = w0 * a[e] + w1 * bb[e] + w2 * c[e];
    store_bf16x8((bf16_t*)(P.ws + WS_AO1) + (size_t)row * 1024 + i * 64 + ch * 8, (f32x4){r[0], r[1], r[2], r[3]}, (f32x4){r[4], r[5], r[6], r[7]});
}
__global__ void __launch_bounds__(256) final_norm(Params P) {
    const int gw = (blockIdx.x * 256 + threadIdx.x) >> 6, lane = threadIdx.x & 63; if (gw >= M) return;
    const float r = rnorm_slots((const float*)(P.ws + WS_SSH) + (size_t)gw * 32, 32, 1.0f / 1024.0f);
    f32x4* h = (f32x4*)(P.out + (size_t)gw * DM) + lane; const f32x4* g = (const f32x4*)P.in[4] + lane;
#pragma unroll
    for (int j = 0; j < 4; ++j) h[64 * j] = h[64 * j] * r * g[64 * j];
}
__global__ void __launch_bounds__(256) prologue_kernel(Params P) {
    __shared__ float scr[4 * 64 * 33];
    const int wave = threadIdx.x >> 6, lane = threadIdx.x & 63;
    prologue_phase(P, scr + wave * 64 * 33, blockIdx.x * 4 + wave, gridDim.x * 4, lane);
}

extern "C" void kernel_launch(void* const* d_in, const int* in_sizes, int n_in, void* d_out, int out_size, void* d_ws, size_t ws_size, hipStream_t stream) {
    Params P{};
    for (int i = 0; i < 22; ++i) P.in[i] = (const float*)d_in[i];
    P.out = (float*)d_out; P.ws = (unsigned char*)d_ws;
    unsigned char* ws = P.ws;
    bf16_t* W = (bf16_t*)(ws + WS_W); bf16_t* HB = (bf16_t*)(ws + WS_HB);
    float* ssh = (float*)(ws + WS_SSH); float* ssl = (float*)(ws + WS_SSL); const float* rope = (const float*)(ws + WS_ROPE);
    prologue_kernel<<<1024, 256, 0, stream>>>(P);
    { EpiProj0 E{ssh, (bf16_t*)(ws + WS_P0)}; naive_gemm<EpiProj0><<<dim3(2304 / 32, M / 256), 256, 0, stream>>>(HB, 1024, W + WO_ABIN, 1024, E); }
    naive_attn_A<<<dim3(32, 32), 256, 0, stream>>>(P);
    combine_A<<<M * 4 * 64 / 256, 256, 0, stream>>>(P);
    naive_banded<0><<<dim3(32, 16), 256, 0, stream>>>(P, 0, 1);
    { EpiResid E{P.in[0], P.out, HB, ssh}; naive_gemm<EpiResid><<<dim3(1024 / 32, M / 256), 256, 0, stream>>>((bf16_t*)(ws + WS_AO0), 1024, W + WO_ABO, 1024, E); }
    { EpiSwiGLU E{ssh, (bf16_t*)(ws + WS_ACT)}; naive_gemm<EpiSwiGLU><<<dim3(2816 / 32, M / 256), 256, 0, stream>>>(HB, 1024, W + WO_GU, 1024, E); }
    { EpiResid E{P.out, P.out, HB, ssh}; naive_gemm<EpiResid><<<dim3(1024 / 32, M / 256), 256, 0, stream>>>((bf16_t*)(ws + WS_ACT), 2816, W + WO_DN, 2816, E); }
    { EpiProj1 E{ssh, ssl, rope, (bf16_t*)(ws + WS_CQ), (bf16_t*)(ws + WS_CK), (bf16_t*)(ws + WS_CV), (bf16_t*)(ws + WS_LAT), (bf16_t*)(ws + WS_KPE)};
      naive_gemm<EpiProj1><<<dim3(3072 / 32, M / 256), 256, 0, stream>>>(HB, 1024, W + WO_CDIN, 1024, E); }
    { EpiQb E{ssl, rope, (bf16_t*)(ws + WS_QD)}; naive_gemm<EpiQb><<<dim3(1280 / 32, M / 256), 256, 0, stream>>>((bf16_t*)(ws + WS_LAT), 768, W + WO_QB, 384, E); }
    { EpiKVb E{ssl, (bf16_t*)(ws + WS_KD), (bf16_t*)(ws + WS_VD)}; naive_gemm<EpiKVb><<<dim3(1536 / 32, M / 256), 256, 0, stream>>>((bf16_t*)(ws + WS_LAT) + 384, 768, W + WO_KVB, 256, E); }
    naive_banded<1><<<dim3(32, 8), 256, 0, stream>>>(P, 0, 1);
    naive_banded<1><<<dim3(32, 8), 256, 0, stream>>>(P, 1, 4);
    naive_banded<1><<<dim3(32, 8), 256, 0, stream>>>(P, 2, 16);
    combine_C<<<M * 32 / 256, 256, 0, stream>>>(P);
    naive_attn_D<<<dim3(32, 24), 256, 0, stream>>>(P);
    { EpiResid E{P.out, P.out, HB, ssh}; naive_gemm<EpiResid><<<dim3(1024 / 32, M / 256), 256, 0, stream>>>((bf16_t*)(ws + WS_AO1), 1024, W + WO_CDO, 1024, E); }
    { EpiSwiGLU E{ssh, (bf16_t*)(ws + WS_ACT)}; naive_gemm<EpiSwiGLU><<<dim3(2816 / 32, M / 256), 256, 0, stream>>>(HB, 1024, W + WO_GU + (size_t)5632 * 1024, 1024, E); }
    { EpiResid E{P.out, P.out, HB, ssh}; naive_gemm<EpiResid><<<dim3(1024 / 32, M / 256), 256, 0, stream>>>((bf16_t*)(ws + WS_ACT), 2816, W + WO_DN + (size_t)1024 * 2816, 2816, E); }
    final_norm<<<M * 64 / 256, 256, 0, stream>>>(P);
}
```

```cpp
#include <hip/hip_runtime.h>
#include <cstdint>
#include <cstdio>

typedef unsigned short bf16_t;
typedef float f32x4 __attribute__((ext_vector_type(4)));
typedef unsigned u32x4 __attribute__((ext_vector_type(4)));
typedef unsigned u32x2 __attribute__((ext_vector_type(2)));

constexpr int BATCH = 2, SEQ = 8192, M = BATCH * SEQ, DM = 1024, DFF = 2816;
constexpr float EPS = 1e-6f, LOG2E = 1.4426950408889634f;
constexpr float C2_64 = 0.125f * LOG2E;
constexpr float C2_96 = 0.10206207261596577f * LOG2E;
constexpr int RBW = 2049;

constexpr size_t MiB = 1u << 20;
constexpr size_t WS_MISCF = 0;
constexpr size_t WS_RB = 64 * 1024;
constexpr size_t WS_ROPE = 256 * 1024;
constexpr size_t WS_LSEC = 1536 * 1024;
constexpr size_t WS_SSH = 3 * MiB;
constexpr size_t WS_SSL = 5 * MiB;
constexpr size_t WS_KPE = 7 * MiB;
constexpr size_t WS_W = 8 * MiB;
constexpr size_t WS_HB = 58 * MiB;
constexpr size_t WS_R = 90 * MiB;
constexpr size_t WS_P0 = WS_R;
constexpr size_t WS_AO0 = WS_R + 72 * MiB;
constexpr size_t WS_ACT = WS_R;
constexpr size_t WS_CQ = WS_R, WS_CK = WS_R + 24 * MiB, WS_CV = WS_R + 48 * MiB;
constexpr size_t WS_LAT = WS_R + 72 * MiB;
constexpr size_t WS_QD = WS_R + 96 * MiB;
constexpr size_t WS_KD = WS_R + 132 * MiB;
constexpr size_t WS_VD = WS_HB;
constexpr size_t WS_AO1 = WS_R + 24 * MiB;
constexpr size_t WO_ABIN = 0;
constexpr size_t WO_ABO = WO_ABIN + (size_t)2304 * 1024;
constexpr size_t WO_CDIN = WO_ABO + (size_t)1024 * 1024;
constexpr size_t WO_QB = WO_CDIN + (size_t)3072 * 1024;
constexpr size_t WO_KVB = WO_QB + (size_t)1280 * 384;
constexpr size_t WO_CDO = WO_KVB + (size_t)1536 * 256;
constexpr size_t WO_GU = WO_CDO + (size_t)1024 * 1024;
constexpr size_t WO_DN = WO_GU + (size_t)2 * 5632 * 1024;
constexpr size_t WO_END = WO_DN + (size_t)2 * 1024 * 2816;
static_assert(WO_END * 2 <= 50 * MiB, "weights fit");

struct Params {
    const float* in[22];
    float* out;
    unsigned char* ws;
};

__device__ __forceinline__ unsigned f2bf(float f) { unsigned u = __builtin_bit_cast(unsigned, f); return (u + 0x7fffu + ((u >> 16) & 1u)) >> 16; }
__device__ __forceinline__ unsigned pk2(float lo, float hi) { return f2bf(lo) | (f2bf(hi) << 16); }
__device__ __forceinline__ float bf2f(unsigned short b) { return __builtin_bit_cast(float, (unsigned)b << 16); }
__device__ __forceinline__ float bflo(unsigned w) { return __builtin_bit_cast(float, w << 16); }
__device__ __forceinline__ float bfhi(unsigned w) { return __builtin_bit_cast(float, w & 0xffff0000u); }
__device__ __forceinline__ void store_bf16x8(bf16_t* p, f32x4 a, f32x4 b) {
    u32x4 w; w.x = pk2(a.x, a.y); w.y = pk2(a.z, a.w); w.z = pk2(b.x, b.y); w.w = pk2(b.z, b.w); *(u32x4*)p = w;
}
__device__ __forceinline__ void store_bf16x4(bf16_t* p, f32x4 a) { u32x2 w; w.x = pk2(a.x, a.y); w.y = pk2(a.z, a.w); *(u32x2*)p = w; }
__device__ __forceinline__ void unpack8(u32x4 w, float* f) {
    f[0] = bflo(w.x); f[1] = bfhi(w.x); f[2] = bflo(w.y); f[3] = bfhi(w.y); f[4] = bflo(w.z); f[5] = bfhi(w.z); f[6] = bflo(w.w); f[7] = bfhi(w.w);
}
__device__ __forceinline__ float wave_sum(float v) {
#pragma unroll
    for (int o = 1; o < 64; o <<= 1) v += __shfl_xor(v, o);
    return v;
}
__device__ __forceinline__ float rnorm_slots(const float* s, int nslots, float invdim) {
    float t = 0.f;
    for (int i = 0; i < nslots; i += 4) { f32x4 v = *(const f32x4*)(s + i); t += (v.x + v.y) + (v.z + v.w); }
    return 1.0f / sqrtf(t * invdim + EPS);
}
__device__ __forceinline__ int pedim(int j) { const int g = j >> 3, i = j & 7; return (i < 4) ? 4 * g + i : 16 + 4 * g + (i - 4); }
__device__ __forceinline__ int t5_bucket(int rel) {
    int ret = rel > 0 ? 16 : 0; int n = rel < 0 ? -rel : rel;
    if (n < 8) return ret + n;
    float nf = (float)n;
    int large = 8 + (int)(logf(nf / 8.0f) / logf(128.0f) * 8.0f);
    if (large > 15) large = 15;
    return ret + large;
}

struct ConvJob { const float* W0; const float* W1; const float* gain; bf16_t* Wt; int K, Nsrc, Nout, kind; };
enum { CK_IDENT = 0, CK_CDIN = 1, CK_QB = 2, CK_GU = 3 };
__device__ __forceinline__ int conv_src(int kind, int n, int& which) {
    which = 0;
    if (kind == CK_IDENT) return n;
    if (kind == CK_CDIN) { if (n < 2944) return n; if (n < 2976) return 2944 + pedim(n - 2944); return -1; }
    if (kind == CK_QB) { if (n >= 1152) return -1; const int g32 = n >> 5, head = g32 / 3, part = g32 % 3; return (part < 2) ? head * 96 + part * 32 + (n & 31) : head * 96 + 64 + pedim(n & 31); }
    { const int tile = n >> 8, w = n & 255; which = (w >= 128); return tile * 128 + (w & 127); }
}
__device__ __forceinline__ ConvJob get_job(const Params& P, int j) {
    bf16_t* W = (bf16_t*)(P.ws + WS_W);
    ConvJob J; J.W1 = nullptr; J.gain = nullptr; J.kind = CK_IDENT;
    switch (j) {
    case 0: J.W0 = P.in[5]; J.gain = P.in[2]; J.Wt = W + WO_ABIN; J.K = 1024; J.Nsrc = 2304; J.Nout = 2304; break;
    case 1: J.W0 = P.in[12]; J.Wt = W + WO_ABO; J.K = 1024; J.Nsrc = 1024; J.Nout = 1024; break;
    case 2: J.W0 = P.in[13]; J.gain = P.in[2] + 1024; J.Wt = W + WO_CDIN; J.K = 1024; J.Nsrc = 2976; J.Nout = 3072; J.kind = CK_CDIN; break;
    case 3: J.W0 = P.in[15]; J.gain = P.in[14]; J.Wt = W + WO_QB; J.K = 384; J.Nsrc = 1152; J.Nout = 1280; J.kind = CK_QB; break;
    case 4: J.W0 = P.in[17]; J.gain = P.in[16]; J.Wt = W + WO_KVB; J.K = 256; J.Nsrc = 1536; J.Nout = 1536; break;
    case 5: J.W0 = P.in[18]; J.Wt = W + WO_CDO; J.K = 1024; J.Nsrc = 1024; J.Nout = 1024; break;
    case 6: case 7: { const int l = j - 6; J.W0 = P.in[19] + (size_t)l * 1024 * 2816; J.W1 = P.in[20] + (size_t)l * 1024 * 2816; J.gain = P.in[3] + l * 1024;
        J.Wt = W + WO_GU + (size_t)l * 5632 * 1024; J.K = 1024; J.Nsrc = 2816; J.Nout = 5632; J.kind = CK_GU; break; }
    default: { const int l = j - 8; J.W0 = P.in[21] + (size_t)l * 2816 * 1024; J.Wt = W + WO_DN + (size_t)l * 1024 * 2816; J.K = 2816; J.Nsrc = 1024; J.Nout = 1024; break; }
    }
    return J;
}
__device__ __forceinline__ int job_items(const ConvJob& J) { return (J.K / 64) * (J.Nout / 32); }
__device__ __forceinline__ void conv_item(const ConvJob& J, float* scr, int item, int lane) {
    const int nblk = J.Nout / 32, kb = item / nblk, nb = item % nblk, k0 = 64 * kb, n0 = 32 * nb;
    int which; const int src = conv_src(J.kind, n0 + (lane & 31), which);
    const float* W = J.W0; if (J.kind == CK_GU && (n0 & 255) >= 128) W = J.W1;
#pragma unroll 8
    for (int i = 0; i < 32; ++i) { const int kk = 2 * i + (lane >> 5); const float g = J.gain ? J.gain[k0 + kk] : 1.0f;
        scr[kk * 33 + (lane & 31)] = (src >= 0) ? W[(size_t)(k0 + kk) * J.Nsrc + src] * g : 0.0f; }
    __builtin_amdgcn_s_waitcnt(0xc07f); asm volatile("" ::: "memory");
    const int c = lane & 7;
#pragma unroll
    for (int j = 0; j < 4; ++j) { const int n = (lane >> 3) + 8 * j; const float* s = scr + (8 * c) * 33 + n;
        u32x4 o; o.x = pk2(s[0 * 33], s[1 * 33]); o.y = pk2(s[2 * 33], s[3 * 33]); o.z = pk2(s[4 * 33], s[5 * 33]); o.w = pk2(s[6 * 33], s[7 * 33]);
        *(u32x4*)(J.Wt + (size_t)(n0 + n) * J.K + k0 + 8 * c) = o; }
    __builtin_amdgcn_s_waitcnt(0xc07f); asm volatile("" ::: "memory");
}
__device__ __forceinline__ void prologue_phase(const Params& P, float* scr, int gw, int ngw, int lane) {
    int base = 0;
#define CONV_JOB(j) { const ConvJob J = get_job(P, j); const int n = job_items(J); int first = (gw - base) % ngw; if (first < 0) first += ngw; \
        for (int it = first; it < n; it += ngw) conv_item(J, scr, it, lane); base += n; }
    CONV_JOB(0) CONV_JOB(1) CONV_JOB(2) CONV_JOB(3) CONV_JOB(4) CONV_JOB(5) CONV_JOB(6) CONV_JOB(7) CONV_JOB(8) CONV_JOB(9)
#undef CONV_JOB
    {
        bf16_t* HB = (bf16_t*)(P.ws + WS_HB); float* ssh = (float*)(P.ws + WS_SSH); const float* x = P.in[0];
        for (int m = gw; m < M; m += ngw) {
            const f32x4* xr = (const f32x4*)(x + (size_t)m * DM) + lane; float s = 0.f; f32x4 v[4];
#pragma unroll
            for (int j = 0; j < 4; ++j) { v[j] = xr[64 * j]; s += (v[j].x * v[j].x + v[j].y * v[j].y) + (v[j].z * v[j].z + v[j].w * v[j].w); }
            s = wave_sum(s);
#pragma unroll
            for (int j = 0; j < 4; ++j) store_bf16x4(HB + (size_t)m * DM + 256 * j + 4 * lane, v[j]);
            if (lane < 32) ssh[(size_t)m * 32 + lane] = (lane == 0) ? s : 0.f;
        }
    }
    const int gt = gw * 64 + lane, ngt = ngw * 64;
    {
        float* RB = (float*)(P.ws + WS_RB); const float* tab = P.in[1];
        for (int i = gt; i < 12 * RBW; i += ngt) { const int h = i / RBW, rel = i % RBW - 1024; RB[i] = tab[t5_bucket(rel) * 12 + h] * LOG2E; }
        float* rope = (float*)(P.ws + WS_ROPE);
        for (int i = gt; i < SEQ * 16; i += ngt) { const int pos = i >> 4, d = i & 15;
            const float inv = powf(10000.0f, -(float)d / 16.0f); const float ang = (float)pos * inv;
            double rev = (double)ang * 0.15915494309189535; rev -= rint(rev); const float fr = (float)rev;
            rope[2 * i] = __builtin_amdgcn_cosf(fr); rope[2 * i + 1] = __builtin_amdgcn_sinf(fr); }
        if (gt == 0) { float a = 0.f, b = 0.f; for (int i = 0; i < 64; ++i) { a += P.in[6][i] * P.in[7][i]; b += P.in[8][i] * P.in[9][i]; }
            ((float*)(P.ws + WS_MISCF))[0] = expf(a) - expf(b) + 0.2f; }
    }
}

struct EpiProj0 {
    const float* ssh; bf16_t* P0;
    static constexpr bool SLOTS = false, PAIR = false;
    __device__ __forceinline__ int brow(int c) const { return c; }
    __device__ __forceinline__ int browp(int c) const { return c; }
    __device__ __forceinline__ float rowctx(int row) const { return rnorm_slots(ssh + (size_t)row * 32, 32, 1.0f / 1024.0f); }
    __device__ __forceinline__ float store8(int row, int col0, float rc, f32x4 a, f32x4 b, f32x4, f32x4) const {
        const float sc = rc * ((col0 < 512 || (col0 >= 1536 && col0 < 2048)) ? C2_64 : 1.0f);
        store_bf16x8(P0 + (size_t)row * 2304 + col0, a * sc, b * sc); return 0.f;
    }
    __device__ __forceinline__ void slot(int, int, float) const {}
};
struct EpiResid {
    const float* Hin; float* Hout; bf16_t* HB; float* ssh;
    static constexpr bool SLOTS = true, PAIR = false;
    __device__ __forceinline__ int brow(int c) const { return c; }
    __device__ __forceinline__ int browp(int c) const { return c; }
    __device__ __forceinline__ float rowctx(int) const { return 1.0f; }
    __device__ __forceinline__ float store8(int row, int col0, float, f32x4 a, f32x4 b, f32x4, f32x4) const {
        const size_t o = (size_t)row * DM + col0;
        const f32x4 h0 = *(const f32x4*)(Hin + o) + a, h1 = *(const f32x4*)(Hin + o + 4) + b;
        *(f32x4*)(Hout + o) = h0; *(f32x4*)(Hout + o + 4) = h1; store_bf16x8(HB + o, h0, h1);
        return (h0.x * h0.x + h0.y * h0.y) + (h0.z * h0.z + h0.w * h0.w) + (h1.x * h1.x + h1.y * h1.y) + (h1.z * h1.z + h1.w * h1.w);
    }
    __device__ __forceinline__ void slot(int row, int s, float v) const { ssh[(size_t)row * 32 + s] = v; }
};
__device__ __forceinline__ float silu_mul(float g, float u) { const float e = __builtin_amdgcn_exp2f(-g * LOG2E); return g * __builtin_amdgcn_rcpf(1.0f + e) * u; }
struct EpiSwiGLU {
    const float* ssh; bf16_t* ACT;
    static constexpr bool SLOTS = false, PAIR = true;
    __device__ __forceinline__ int brow(int c) const { return (c >> 7) * 256 + (c & 127); }
    __device__ __forceinline__ int browp(int c) const { return brow(c) + 128; }
    __device__ __forceinline__ float rowctx(int row) const { return rnorm_slots(ssh + (size_t)row * 32, 32, 1.0f / 1024.0f); }
    __device__ __forceinline__ float store8(int row, int col0, float rc, f32x4 a, f32x4 b, f32x4 pa, f32x4 pb) const {
        a = a * rc; b = b * rc; pa = pa * rc; pb = pb * rc; f32x4 o0, o1;
        o0.x = silu_mul(a.x, pa.x); o0.y = silu_mul(a.y, pa.y); o0.z = silu_mul(a.z, pa.z); o0.w = silu_mul(a.w, pa.w);
        o1.x = silu_mul(b.x, pb.x); o1.y = silu_mul(b.y, pb.y); o1.z = silu_mul(b.z, pb.z); o1.w = silu_mul(b.w, pb.w);
        store_bf16x8(ACT + (size_t)row * DFF + col0, o0, o1); return 0.f;
    }
    __device__ __forceinline__ void slot(int, int, float) const {}
};
__device__ __forceinline__ void rope4(const float* rope, int pos, int grp, f32x4 a, f32x4 b, f32x4& o1, f32x4& o2) {
    const f32x4* r = (const f32x4*)(rope + ((size_t)pos * 16 + 4 * grp) * 2);
    const f32x4 r0 = r[0], r1 = r[1];
    o1.x = a.x * r0.x - b.x * r0.y; o2.x = b.x * r0.x + a.x * r0.y;
    o1.y = a.y * r0.z - b.y * r0.w; o2.y = b.y * r0.z + a.y * r0.w;
    o1.z = a.z * r1.x - b.z * r1.y; o2.z = b.z * r1.x + a.z * r1.y;
    o1.w = a.w * r1.z - b.w * r1.w; o2.w = b.w * r1.z + a.w * r1.w;
}
struct EpiProj1 {
    const float* ssh; float* ssl; const float* rope; bf16_t *CQ, *CK, *CV, *LAT, *KPE;
    static constexpr bool SLOTS = true, PAIR = false;
    __device__ __forceinline__ int brow(int c) const { return c; }
    __device__ __forceinline__ int browp(int c) const { return c; }
    __device__ __forceinline__ float rowctx(int row) const { return rnorm_slots(ssh + (size_t)row * 32, 32, 1.0f / 1024.0f); }
    __device__ __forceinline__ float store8(int row, int col0, float rc, f32x4 a, f32x4 b, f32x4, f32x4) const {
        a = a * rc; b = b * rc;
        if (col0 < 768) { store_bf16x8(CQ + (size_t)row * 768 + col0, a * C2_64, b * C2_64); return 0.f; }
        if (col0 < 1536) { store_bf16x8(CK + (size_t)row * 768 + (col0 - 768), a, b); return 0.f; }
        if (col0 < 2304) { store_bf16x8(CV + (size_t)row * 768 + (col0 - 1536), a, b); return 0.f; }
        const int c = col0 - 2304;
        if (c < 640) { store_bf16x8(LAT + (size_t)row * 768 + c, a, b);
            return (a.x * a.x + a.y * a.y) + (a.z * a.z + a.w * a.w) + (b.x * b.x + b.y * b.y) + (b.z * b.z + b.w * b.w); }
        if (c < 672) { const int grp = (c - 640) >> 3; f32x4 o1, o2; rope4(rope, row & (SEQ - 1), grp, a, b, o1, o2);
            store_bf16x4(KPE + (size_t)row * 32 + 4 * grp, o1); store_bf16x4(KPE + (size_t)row * 32 + 16 + 4 * grp, o2); }
        return 0.f;
    }
    __device__ __forceinline__ void slot(int row, int s, float v) const { if (s >= 72 && s < 92) ssl[(size_t)row * 32 + (s - 72)] = v; }
};
struct EpiQb {
    const float* ssl; const float* rope; bf16_t* QD;
    static constexpr bool SLOTS = false, PAIR = false;
    __device__ __forceinline__ int brow(int c) const { return c; }
    __device__ __forceinline__ int browp(int c) const { return c; }
    __device__ __forceinline__ float rowctx(int row) const { return rnorm_slots(ssl + (size_t)row * 32, 12, 1.0f / 384.0f); }
    __device__ __forceinline__ float store8(int row, int col0, float rc, f32x4 a, f32x4 b, f32x4, f32x4) const {
        if (col0 >= 1152) return 0.f;
        const float sc = rc * C2_96; a = a * sc; b = b * sc;
        const int g32 = col0 >> 5, head = g32 / 3, part = g32 % 3;
        bf16_t* q = QD + (size_t)row * 1152 + head * 96;
        if (part < 2) { store_bf16x8(q + part * 32 + (col0 & 31), a, b); return 0.f; }
        const int grp = (col0 & 31) >> 3; f32x4 o1, o2; rope4(rope, row & (SEQ - 1), grp, a, b, o1, o2);
        store_bf16x4(q + 64 + 4 * grp, o1); store_bf16x4(q + 80 + 4 * grp, o2); return 0.f;
    }
    __device__ __forceinline__ void slot(int, int, float) const {}
};
struct EpiKVb {
    const float* ssl; bf16_t *KD, *VD;
    static constexpr bool SLOTS = false, PAIR = false;
    __device__ __forceinline__ int brow(int c) const { return c; }
    __device__ __forceinline__ int browp(int c) const { return c; }
    __device__ __forceinline__ float rowctx(int row) const { return rnorm_slots(ssl + (size_t)row * 32 + 12, 8, 1.0f / 256.0f); }
    __device__ __forceinline__ float store8(int row, int col0, float rc, f32x4 a, f32x4 b, f32x4, f32x4) const {
        a = a * rc; b = b * rc; const int head = col0 >> 7, w = col0 & 127;
        if (w < 64) store_bf16x8(KD + (size_t)row * 768 + head * 64 + w, a, b); else store_bf16x8(VD + (size_t)row * 768 + head * 64 + (w - 64), a, b);
        return 0.f;
    }
    __device__ __forceinline__ void slot(int, int, float) const {}
};


namespace pg8 {
#define PG8_LAS __attribute__((address_space(3)))
typedef unsigned short bf16_t;
typedef short bf16x8 __attribute__((ext_vector_type(8)));
typedef float f32x4 __attribute__((ext_vector_type(4)));
typedef unsigned u32x4 __attribute__((ext_vector_type(4)));
constexpr int BM = 256, BK = 64, HALF = 128, HTB = HALF * BK * 2  , STAGE_BYTES = 8 * HTB, NXCD = 8, WGM = 8;

__host__ __device__ __forceinline__ int lds_byte(int r, int c) { const int st = (r >> 4) * 2 + (c >> 5), rr = r & 15, cc = c & 31, ob = rr * 64 + cc * 2; return st * 1024 + (ob ^ (((ob >> 9) & 1) << 5)); }
__host__ __device__ __forceinline__ void stage_rc(int b, int& R, int& C) { const int st = b / 1024, sb = b % 1024, swz = sb ^ (((sb >> 9) & 1) << 5); R = (st >> 1) * 16 + swz / 64; C = (st & 1) * 32 + (swz % 64) / 2; }
__host__ __device__ __forceinline__ int perm32(int rho) { const int n = rho >> 4, i = rho & 15; return 8 * (i >> 2) + 4 * n + (i & 3); }

struct Unit { int pm, pn; };
struct Gemm { const bf16_t* A; const bf16_t* Bt; int M, N, K, lda; };

struct StaticOrder {
    int nM, nN, nwg, G, c;
    __host__ __device__ void init(int M, int N, int G_, int c_) { nM = M / BM; nN = N / BM; nwg = nM * nN; G = G_; c = c_; }
    __host__ __device__ bool next(int i, Unit& u) const {
        const long L = (long)i * G + c; if (L >= nwg) return false;
        int wgid = (int)L; { const int q = nwg / NXCD, r = nwg % NXCD, xcd = wgid % NXCD, off = wgid / NXCD; wgid = (xcd < r ? xcd * (q + 1) : r * (q + 1) + (xcd - r) * q) + off; }
        const int nig = WGM * nN, gid = wgid / nig, fm = gid * WGM, gsz = (nM - fm) < WGM ? (nM - fm) : WGM;
        u.pm = fm + ((wgid % nig) % gsz); u.pn = (wgid % nig) / gsz; return true;
    }
    __device__ __forceinline__ void a_ready(const Unit&) const {}
    __device__ __forceinline__ void done(const Unit&) const {}
};


template <class Epi, class Sched, bool ALIGN_EPI = false, bool SP2 = false>
__device__ __forceinline__ void gemm_phase(PG8_LAS unsigned char* lds, const Gemm g, const Sched& S, const Epi& E) {
    const int tid = threadIdx.x, wid = __builtin_amdgcn_readfirstlane(tid >> 6), lane = tid & 63, wr = wid >> 2, wc = wid & 3, fr = lane & 15, fq = lane >> 4;
    const int K = g.K, nt = K / BK;
    unsigned voffA[2], voffB[2];
#pragma unroll
    for (int i = 0; i < 2; ++i) { int R, C; stage_rc(tid * 16 + i * 8192, R, C); const int Rb = Epi::PERM ? ((R & ~31) + perm32(R & 31)) : R;
        voffA[i] = (unsigned)(R * g.lda + C) * 2u; voffB[i] = (unsigned)(Rb * K + C) * 2u; }
    const size_t kstep = (size_t)(BK * 2);
    const size_t hstepA = (size_t)HALF * g.lda * 2, hstepB = (size_t)HALF * K * 2;
    const size_t tstepA = 2 * hstepA, tstepB = 2 * hstepB;
    const unsigned ldsw = (unsigned)wid * 1024u;
    const int aoff = lds_byte(wr * 64 + fr, fq * 8), boff = lds_byte(wc * 32 + fr, fq * 8);
#define PG8_SA(b, h) (((b) * 2 + (h)) * HTB)
#define PG8_SB(b, h) ((4 + (b) * 2 + (h)) * HTB)
#define PG8_STAGE(bufoff, gbase, voff) do { _Pragma("unroll") for (int _i = 0; _i < 2; ++_i) \
        __builtin_amdgcn_global_load_lds((const unsigned*)((const char*)(gbase) + (voff)[_i]), (PG8_LAS unsigned*)(lds + (bufoff) + ldsw + _i * 8192), 16, 0, 0); } while (0)
#define PG8_LDA(dst, b, h) do { _Pragma("unroll") for (int m = 0; m < 4; ++m) _Pragma("unroll") for (int k = 0; k < 2; ++k) dst[m][k] = *(const PG8_LAS bf16x8*)(lds + PG8_SA(b, h) + aoff + m * 2048 + k * 1024); } while (0)
#define PG8_LDB(dst, b, h) do { _Pragma("unroll") for (int n = 0; n < 2; ++n) _Pragma("unroll") for (int k = 0; k < 2; ++k) dst[n][k] = *(const PG8_LAS bf16x8*)(lds + PG8_SB(b, h) + boff + n * 2048 + k * 1024); } while (0)
#define PG8_MMA(ai, bj, At, Bt) do { __builtin_amdgcn_s_setprio(1); _Pragma("unroll") for (int m = 0; m < 4; ++m) _Pragma("unroll") for (int n = 0; n < 2; ++n) _Pragma("unroll") for (int k = 0; k < 2; ++k) \
        acc[ai][bj][m][n] = __builtin_amdgcn_mfma_f32_16x16x32_bf16(Bt[n][k], At[m][k], acc[ai][bj][m][n], 0, 0, 0); __builtin_amdgcn_s_setprio(0); } while (0)
#define PG8_WAIT_V(n) asm volatile("s_waitcnt vmcnt(" #n ")" ::: "memory")
#define PG8_WAIT_L(n) asm volatile("s_waitcnt lgkmcnt(" #n ")" ::: "memory")
#define PG8_BAR __builtin_amdgcn_s_barrier()
#define PG8_SCHED __builtin_amdgcn_sched_barrier(0)
    Unit cur, nxt; int ui = 0;
    if (!S.next(0, cur)) return;
    f32x4 acc[2][2][4][2];
#pragma unroll
    for (int a = 0; a < 2; ++a)
#pragma unroll
        for (int b = 0; b < 2; ++b)
#pragma unroll
            for (int m = 0; m < 4; ++m)
#pragma unroll
                for (int n = 0; n < 2; ++n) acc[a][b][m][n] = (f32x4){0.f, 0.f, 0.f, 0.f};
    bf16x8 At[4][2], B0[2][2], B1[2][2];
    const char* cA = (const char*)g.A + (size_t)cur.pm * tstepA; const char* cB = (const char*)g.Bt + (size_t)cur.pn * tstepB;
    S.a_ready(cur);
    if constexpr (SP2) {
        PG8_STAGE(PG8_SB(0, 0), cB, voffB); PG8_STAGE(PG8_SB(0, 1), cB + hstepB, voffB); PG8_STAGE(PG8_SA(0, 0), cA, voffA); PG8_STAGE(PG8_SA(0, 1), cA + hstepA, voffA);
        if (wr == 1) PG8_BAR;
        PG8_WAIT_V(2); PG8_BAR;
        PG8_STAGE(PG8_SB(1, 0), cB + kstep, voffB); PG8_STAGE(PG8_SA(1, 0), cA + kstep, voffA); PG8_STAGE(PG8_SB(1, 1), cB + hstepB + kstep, voffB);
        PG8_WAIT_V(6); PG8_BAR;
    } else {
        PG8_STAGE(PG8_SB(0, 0), cB, voffB); PG8_STAGE(PG8_SA(0, 0), cA, voffA); PG8_STAGE(PG8_SB(0, 1), cB + hstepB, voffB); PG8_STAGE(PG8_SA(0, 1), cA + hstepA, voffA);
        if (wr == 1) PG8_BAR;
        PG8_WAIT_V(4); PG8_BAR;
        PG8_STAGE(PG8_SB(1, 0), cB + kstep, voffB); PG8_STAGE(PG8_SA(1, 0), cA + kstep, voffA); PG8_STAGE(PG8_SB(1, 1), cB + hstepB + kstep, voffB);
        PG8_WAIT_V(6); PG8_BAR;
    }
    for (;;) {
        const bool has_next = S.next(ui + 1, nxt);
        const char* nA = has_next ? (const char*)g.A + (size_t)nxt.pm * tstepA : cA; const char* nB = has_next ? (const char*)g.Bt + (size_t)nxt.pn * tstepB : cB;
        for (int t = 0; t < nt; t += 2) {
            const bool last = (t == nt - 2);
            const char* a1 = cA + (size_t)(t + 1) * kstep;
            const char* a2 = last ? nA : cA + (size_t)(t + 2) * kstep; const char* b2 = last ? nB : cB + (size_t)(t + 2) * kstep;
            const char* a3 = a2 + kstep; const char* b3 = b2 + kstep;
            if (last && has_next) S.a_ready(nxt);
            if constexpr (SP2) {
            PG8_LDB(B0, 0, 0); PG8_LDB(B1, 0, 1); PG8_SCHED; PG8_LDA(At, 0, 0); PG8_STAGE(PG8_SA(1, 1), a1 + hstepA, voffA);
            PG8_WAIT_V(8); PG8_WAIT_L(0); PG8_BAR; PG8_MMA(0, 0, At, B0); PG8_MMA(0, 1, At, B1); PG8_BAR; PG8_SCHED;
            PG8_LDA(At, 0, 1); PG8_STAGE(PG8_SB(0, 0), b2, voffB); PG8_STAGE(PG8_SB(0, 1), b2 + hstepB, voffB); PG8_STAGE(PG8_SA(0, 0), a2, voffA);
            PG8_WAIT_V(8); PG8_WAIT_L(0); PG8_BAR; PG8_MMA(1, 0, At, B0); PG8_MMA(1, 1, At, B1); PG8_BAR; PG8_SCHED;
            PG8_LDB(B0, 1, 0); PG8_LDB(B1, 1, 1); PG8_SCHED; PG8_LDA(At, 1, 0); PG8_STAGE(PG8_SA(0, 1), a2 + hstepA, voffA);
            PG8_WAIT_V(8); PG8_WAIT_L(0); PG8_BAR; PG8_MMA(0, 0, At, B0); PG8_MMA(0, 1, At, B1); PG8_BAR; PG8_SCHED;
            PG8_LDA(At, 1, 1); PG8_STAGE(PG8_SB(1, 0), b3, voffB); PG8_STAGE(PG8_SB(1, 1), b3 + hstepB, voffB); PG8_STAGE(PG8_SA(1, 0), a3, voffA);
            PG8_WAIT_V(8); PG8_WAIT_L(0); PG8_BAR; PG8_MMA(1, 0, At, B0); PG8_MMA(1, 1, At, B1); PG8_BAR; PG8_SCHED;
            } else {
            PG8_LDB(B0, 0, 0); PG8_SCHED; PG8_LDA(At, 0, 0); PG8_STAGE(PG8_SA(1, 1), a1 + hstepA, voffA);
            PG8_WAIT_L(8); PG8_BAR; PG8_WAIT_L(0); PG8_MMA(0, 0, At, B0); PG8_BAR; PG8_SCHED;
            PG8_LDB(B1, 0, 1); PG8_STAGE(PG8_SB(0, 0), b2, voffB);
            PG8_BAR; PG8_WAIT_L(0); PG8_MMA(0, 1, At, B1); PG8_BAR;
            PG8_LDA(At, 0, 1); PG8_STAGE(PG8_SA(0, 0), a2, voffA);
            PG8_BAR; PG8_WAIT_L(0); PG8_MMA(1, 0, At, B0); PG8_BAR; PG8_SCHED;
            PG8_STAGE(PG8_SB(0, 1), b2 + hstepB, voffB);
            PG8_WAIT_V(6); PG8_BAR; PG8_MMA(1, 1, At, B1); PG8_BAR;
            PG8_LDB(B0, 1, 0); PG8_SCHED; PG8_LDA(At, 1, 0); PG8_STAGE(PG8_SA(0, 1), a2 + hstepA, voffA);
            PG8_WAIT_L(8); PG8_BAR; PG8_WAIT_L(0); PG8_MMA(0, 0, At, B0); PG8_BAR; PG8_SCHED;
            PG8_LDB(B1, 1, 1); PG8_STAGE(PG8_SB(1, 0), b3, voffB);
            PG8_BAR; PG8_WAIT_L(0); PG8_MMA(0, 1, At, B1); PG8_BAR;
            PG8_LDA(At, 1, 1); PG8_STAGE(PG8_SA(1, 0), a3, voffA);
            PG8_BAR; PG8_WAIT_L(0); PG8_MMA(1, 0, At, B0); PG8_BAR; PG8_SCHED;
            PG8_STAGE(PG8_SB(1, 1), b3 + hstepB, voffB);
            PG8_WAIT_V(6); PG8_BAR; PG8_MMA(1, 1, At, B1); PG8_BAR;
            }
        }
        if constexpr (ALIGN_EPI) { if (wr == 0) PG8_BAR; }
        if constexpr (!Epi::AFTER_DRAIN) { E(acc, cur, wr, wc, fr, fq); S.done(cur); }
        if (!has_next) break;
#pragma unroll
        for (int a = 0; a < 2; ++a)
#pragma unroll
            for (int b = 0; b < 2; ++b)
#pragma unroll
                for (int m = 0; m < 4; ++m)
#pragma unroll
                    for (int n = 0; n < 2; ++n) acc[a][b][m][n] = (f32x4){0.f, 0.f, 0.f, 0.f};
        cur = nxt; cA = nA; cB = nB; ++ui;
        if constexpr (ALIGN_EPI) { if (wr == 1) PG8_BAR; }
    }
    PG8_WAIT_V(0);
    if constexpr (!ALIGN_EPI) { if (wr == 0) PG8_BAR; }
    PG8_BAR;
    if constexpr (Epi::AFTER_DRAIN) { E.fused(acc, cur, wr, wc, fr, fq, lds, wid, lane); S.done(cur); }
#undef PG8_SA
#undef PG8_SB
#undef PG8_STAGE
#undef PG8_LDA
#undef PG8_LDB
#undef PG8_MMA
#undef PG8_WAIT_V
#undef PG8_WAIT_L
#undef PG8_BAR
#undef PG8_SCHED
}
}

template <class E> struct EpiAdapt {
    static constexpr bool PERM = true, AFTER_DRAIN = false;
    E e;
    __device__ __forceinline__ void operator()(const pg8::f32x4 (&acc)[2][2][4][2], const pg8::Unit& u, int wr, int wc, int fr, int fq) const {
#pragma unroll
        for (int ai = 0; ai < 2; ++ai)
#pragma unroll
            for (int m = 0; m < 4; ++m) {
                const int row = u.pm * 256 + ai * 128 + wr * 64 + m * 16 + fr; const float rc = e.rowctx(row);
                if (!E::PAIR) {
#pragma unroll
                    for (int bj = 0; bj < 2; ++bj) { const int col0 = u.pn * 256 + bj * 128 + wc * 32 + 8 * fq;
                        float ss = e.store8(row, col0, rc, acc[ai][bj][m][0], acc[ai][bj][m][1], acc[ai][bj][m][0], acc[ai][bj][m][1]);
                        if (E::SLOTS) { ss += __shfl_xor(ss, 16); ss += __shfl_xor(ss, 32); if (fq == 0) e.slot(row, col0 >> 5, ss); } }
                } else {
                    const int col0 = u.pn * 128 + wc * 32 + 8 * fq;
                    (void)e.store8(row, col0, rc, acc[ai][0][m][0], acc[ai][0][m][1], acc[ai][1][m][0], acc[ai][1][m][1]);
                }
            }
    }
};
constexpr int GEMM_LDS_BYTES = pg8::STAGE_BYTES;
template <class E>
__device__ __forceinline__ void gemm_run(PG8_LAS unsigned char* lds, const bf16_t* A, int lda, const bf16_t* Bt, int N, int K, const E& e, int G, int c) {
    pg8::Gemm g{A, Bt, M, N, K, lda}; pg8::StaticOrder S; S.init(M, N, G, c);
    EpiAdapt<E> EA{e};
    pg8::gemm_phase<EpiAdapt<E>, pg8::StaticOrder, true, true>(lds, g, S, EA);
}
template <class E>
__global__ void __launch_bounds__(512, 2) gemm_kernel(const bf16_t* A, int lda, const bf16_t* Bt, int N, int K, E e) {
    extern __shared__ __attribute__((aligned(16))) unsigned char dynlds[];
    gemm_run<E>((PG8_LAS unsigned char*)dynlds, A, lda, Bt, N, K, e, (int)gridDim.x, (int)blockIdx.x);
}

template <class Epi>
__global__ void __launch_bounds__(256) naive_gemm(const bf16_t* A, int lda, const bf16_t* Bt, int K, Epi E) {
    __shared__ float As[256 * 33];
    __shared__ float Bs[2][32 * 36];
    const int tid = threadIdx.x, cg = tid & 3, rg = tid >> 2;
    const int c0 = blockIdx.x * 32, r0 = blockIdx.y * 256, col0 = c0 + cg * 8;
    float acc[4][8], accp[4][8];
#pragma unroll
    for (int i = 0; i < 4; ++i)
#pragma unroll
        for (int j = 0; j < 8; ++j) { acc[i][j] = 0.f; accp[i][j] = 0.f; }
    for (int k0 = 0; k0 < K; k0 += 32) {
        {
            const u32x4* ap = (const u32x4*)(A + (size_t)(r0 + tid) * lda + k0);
#pragma unroll
            for (int q = 0; q < 4; ++q) { float f[8]; unpack8(ap[q], f);
#pragma unroll
                for (int e = 0; e < 8; ++e) As[tid * 33 + q * 8 + e] = f[e]; }
        }
        {
            const int pr = tid >> 7, t = tid & 127, c = t >> 2, q = t & 3;
            if (pr == 0 || Epi::PAIR) {
                const int br = pr ? E.browp(c0 + c) : E.brow(c0 + c);
                float f[8]; unpack8(*(const u32x4*)(Bt + (size_t)br * K + k0 + q * 8), f);
#pragma unroll
                for (int e = 0; e < 8; ++e) Bs[pr][(q * 8 + e) * 36 + c] = f[e];
            }
        }
        __syncthreads();
#pragma unroll 4
        for (int k = 0; k < 32; ++k) {
            float a[4];
#pragma unroll
            for (int i = 0; i < 4; ++i) a[i] = As[(rg + 64 * i) * 33 + k];
            const f32x4 b0 = *(const f32x4*)&Bs[0][k * 36 + cg * 8], b1 = *(const f32x4*)&Bs[0][k * 36 + cg * 8 + 4];
            const float bb[8] = {b0.x, b0.y, b0.z, b0.w, b1.x, b1.y, b1.z, b1.w};
#pragma unroll
            for (int i = 0; i < 4; ++i)
#pragma unroll
                for (int j = 0; j < 8; ++j) acc[i][j] += a[i] * bb[j];
            if (Epi::PAIR) {
                const f32x4 p0 = *(const f32x4*)&Bs[1][k * 36 + cg * 8], p1 = *(const f32x4*)&Bs[1][k * 36 + cg * 8 + 4];
                const float pp[8] = {p0.x, p0.y, p0.z, p0.w, p1.x, p1.y, p1.z, p1.w};
#pragma unroll
                for (int i = 0; i < 4; ++i)
#pragma unroll
                    for (int j = 0; j < 8; ++j) accp[i][j] += a[i] * pp[j];
            }
        }
        __syncthreads();
    }
#pragma unroll
    for (int i = 0; i < 4; ++i) {
        const int row = r0 + rg + 64 * i; const float rc = E.rowctx(row);
        float ss = E.store8(row, col0, rc, (f32x4){acc[i][0], acc[i][1], acc[i][2], acc[i][3]}, (f32x4){acc[i][4], acc[i][5], acc[i][6], acc[i][7]},
                            (f32x4){accp[i][0], accp[i][1], accp[i][2], accp[i][3]}, (f32x4){accp[i][4], accp[i][5], accp[i][6], accp[i][7]});
        if (Epi::SLOTS) { ss += __shfl_xor(ss, 1); ss += __shfl_xor(ss, 2); if (cg == 0) E.slot(row, col0 >> 5, ss); }
    }
}

template <int DQK, bool BIAS>
__device__ __forceinline__ void naive_dense_block(const bf16_t* Q, int qpitch, const bf16_t* K1, int k1pitch, const bf16_t* K2, int k2pitch,
                                                  const bf16_t* V, int vpitch, const float* RBh, int qpos0, float* outF, int opF, bf16_t* outB, int opB) {
    __shared__ float Ks[16 * DQK];
    __shared__ float Vs[16 * 64];
    const int tid = threadIdx.x;
    float q[DQK], o[64];
    {
        const bf16_t* qp = Q + (size_t)tid * qpitch;
#pragma unroll
        for (int c = 0; c < DQK / 8; ++c) unpack8(*(const u32x4*)(qp + c * 8), q + c * 8);
    }
#pragma unroll
    for (int d = 0; d < 64; ++d) o[d] = 0.f;
    float m = -1e30f, l = 0.f;
    const int qpos = qpos0 + tid;
    constexpr int NCH = 16 * (DQK / 8) + 16 * 8;
    for (int kt = 0; kt < SEQ; kt += 16) {
        for (int c = tid; c < NCH; c += 256) {
            if (c < 16 * (DQK / 8)) { const int key = c / (DQK / 8), ch = c % (DQK / 8);
                const bf16_t* src = (ch < 8) ? K1 + (size_t)(kt + key) * k1pitch + ch * 8 : K2 + (size_t)(kt + key) * k2pitch + (ch - 8) * 8;
                float f[8]; unpack8(*(const u32x4*)src, f);
#pragma unroll
                for (int e = 0; e < 8; ++e) Ks[key * DQK + ch * 8 + e] = f[e];
            } else { const int c2 = c - 16 * (DQK / 8), key = c2 >> 3, ch = c2 & 7;
                float f[8]; unpack8(*(const u32x4*)(V + (size_t)(kt + key) * vpitch + ch * 8), f);
#pragma unroll
                for (int e = 0; e < 8; ++e) Vs[key * 64 + ch * 8 + e] = f[e];
            }
        }
        __syncthreads();
        float s[16]; float tmax = -1e30f;
#pragma unroll
        for (int j = 0; j < 16; ++j) {
            float a = 0.f;
#pragma unroll
            for (int d = 0; d < DQK; d += 4) { const f32x4 kv = *(const f32x4*)&Ks[j * DQK + d]; a += q[d] * kv.x + q[d + 1] * kv.y + q[d + 2] * kv.z + q[d + 3] * kv.w; }
            if (BIAS) { int rel = kt + j - qpos; rel = rel < -1024 ? -1024 : (rel > 1024 ? 1024 : rel); a += RBh[rel + 1024]; }
            s[j] = a; tmax = fmaxf(tmax, a);
        }
        const float mn = fmaxf(m, tmax), alpha = __builtin_amdgcn_exp2f(m - mn);
        m = mn; l *= alpha;
#pragma unroll
        for (int d = 0; d < 64; ++d) o[d] *= alpha;
#pragma unroll
        for (int j = 0; j < 16; ++j) {
            const float p = __builtin_amdgcn_exp2f(s[j] - mn); l += p;
#pragma unroll
            for (int d = 0; d < 64; d += 4) { const f32x4 vv = *(const f32x4*)&Vs[j * 64 + d]; o[d] += p * vv.x; o[d + 1] += p * vv.y; o[d + 2] += p * vv.z; o[d + 3] += p * vv.w; }
        }
        __syncthreads();
    }
    const float il = 1.0f / l;
    if (outF) { float* op = outF + (size_t)tid * opF;
#pragma unroll
        for (int d = 0; d < 64; d += 4) *(f32x4*)(op + d) = (f32x4){o[d] * il, o[d + 1] * il, o[d + 2] * il, o[d + 3] * il}; }
    else { bf16_t* op = outB + (size_t)tid * opB;
#pragma unroll
        for (int d = 0; d < 64; d += 8) store_bf16x8(op + d, (f32x4){o[d] * il, o[d + 1] * il, o[d + 2] * il, o[d + 3] * il}, (f32x4){o[d + 4] * il, o[d + 5] * il, o[d + 6] * il, o[d + 7] * il}); }
}
__global__ void __launch_bounds__(256) naive_attn_A(Params P) {
    const int qb = blockIdx.x, y = blockIdx.y, b = y >> 4, h = (y >> 2) & 3, sm = (y >> 1) & 1, vh = y & 1;
    const bf16_t* P0 = (const bf16_t*)(P.ws + WS_P0);
    const size_t row0 = (size_t)b * SEQ;
    naive_dense_block<64, true>(P0 + (row0 + qb * 256) * 2304 + h * 128 + sm * 64, 2304,
                                P0 + row0 * 2304 + 512 + h * 128 + sm * 64, 2304, nullptr, 0,
                                P0 + row0 * 2304 + 1024 + h * 128 + vh * 64, 2304,
                                (const float*)(P.ws + WS_RB) + h * RBW, qb * 256,
                                P.out + (size_t)sm * M * 512 + (row0 + qb * 256) * 512 + h * 128 + vh * 64, 512, nullptr, 0);
}
__global__ void __launch_bounds__(256) naive_attn_D(Params P) {
    const int qb = blockIdx.x, y = blockIdx.y, b = y / 12, h = y % 12;
    const size_t row0 = (size_t)b * SEQ;
    naive_dense_block<96, false>((const bf16_t*)(P.ws + WS_QD) + (row0 + qb * 256) * 1152 + h * 96, 1152,
                                 (const bf16_t*)(P.ws + WS_KD) + row0 * 768 + h * 64, 768, (const bf16_t*)(P.ws + WS_KPE) + row0 * 32, 32,
                                 (const bf16_t*)(P.ws + WS_VD) + row0 * 768 + h * 64, 768, nullptr, qb * 256,
                                 nullptr, 0, (bf16_t*)(P.ws + WS_AO1) + (row0 + qb * 256) * 1024 + 256 + h * 64, 1024);
}
__global__ void __launch_bounds__(256) combine_A(Params P) {
    const int gw = (blockIdx.x * 256 + threadIdx.x) >> 6, lane = threadIdx.x & 63;
    if (gw >= M * 4) return;
    const int row = gw >> 2, h = gw & 3;
    const float lam = ((const float*)(P.ws + WS_MISCF))[0];
    const float* o1 = P.out + (size_t)row * 512 + h * 128 + 2 * lane; const float* o2 = o1 + (size_t)M * 512;
    const float x0 = o1[0] - lam * o2[0], x1 = o1[1] - lam * o2[1];
    const float ss = wave_sum(x0 * x0 + x1 * x1), r = 1.0f / sqrtf(ss * (1.0f / 128.0f) + EPS);
    const float* g = P.in[10];
    bf16_t* ao = (bf16_t*)(P.ws + WS_AO0) + (size_t)row * 1024 + h * 128 + 2 * lane;
    *(unsigned*)ao = pk2(x0 * r * g[2 * lane] * 0.8f, x1 * r * g[2 * lane + 1] * 0.8f);
}

template <int MODE>
__global__ void __launch_bounds__(256) naive_banded(Params P, int grp, int dil) {
    const int p = blockIdx.x * 256 + threadIdx.x, y = blockIdx.y;
    int b, hh, W, bcol; const bf16_t *Q, *K, *V; int pitch;
    if (MODE == 0) { b = y >> 3; hh = y & 7; W = 128; bcol = 4 + hh; pitch = 2304;
        const bf16_t* P0 = (const bf16_t*)(P.ws + WS_P0) + (size_t)b * SEQ * 2304;
        Q = P0 + 1536 + hh * 64; K = P0 + 2048 + (hh >> 2) * 64; V = P0 + 2176 + (hh >> 2) * 64; }
    else { b = y >> 2; hh = grp * 4 + (y & 3); W = 64; bcol = hh; pitch = 768;
        Q = (const bf16_t*)(P.ws + WS_CQ) + (size_t)b * SEQ * 768 + hh * 64; K = (const bf16_t*)(P.ws + WS_CK) + (size_t)b * SEQ * 768 + hh * 64; V = (const bf16_t*)(P.ws + WS_CV) + (size_t)b * SEQ * 768 + hh * 64; }
    const float* RBh = (const float*)(P.ws + WS_RB) + bcol * RBW;
    float q[64], o[64];
#pragma unroll
    for (int c = 0; c < 8; ++c) unpack8(*(const u32x4*)(Q + (size_t)p * pitch + c * 8), q + c * 8);
#pragma unroll
    for (int d = 0; d < 64; ++d) o[d] = 0.f;
    float m = -1e30f, l = 0.f;
    if (MODE == 0) { m = P.in[11][hh] * LOG2E; l = 1.0f; }
    for (int mm = -W; mm <= W; ++mm) {
        const int kp = p + mm * dil;
        if (kp < 0 || kp >= SEQ) continue;
        float kf[8], a = 0.f;
#pragma unroll
        for (int c = 0; c < 8; ++c) { unpack8(*(const u32x4*)(K + (size_t)kp * pitch + c * 8), kf);
#pragma unroll
            for (int e = 0; e < 8; ++e) a += q[c * 8 + e] * kf[e]; }
        a += RBh[mm * dil + 1024];
        const float mn = fmaxf(m, a), alpha = __builtin_amdgcn_exp2f(m - mn), pe = __builtin_amdgcn_exp2f(a - mn);
        m = mn; l = l * alpha + pe;
#pragma unroll
        for (int c = 0; c < 8; ++c) { unpack8(*(const u32x4*)(V + (size_t)kp * pitch + c * 8), kf);
#pragma unroll
            for (int e = 0; e < 8; ++e) o[c * 8 + e] = o[c * 8 + e] * alpha + pe * kf[e]; }
    }
    const float il = 1.0f / l; const size_t row = (size_t)b * SEQ + p;
    bf16_t* op;
    if (MODE == 0) op = (bf16_t*)(P.ws + WS_AO0) + row * 1024 + 512 + hh * 64;
    else { op = (bf16_t*)(P.ws + WS_CQ) + row * 768 + hh * 64; ((float*)(P.ws + WS_LSEC))[((size_t)grp * M + row) * 4 + (y & 3)] = m + __builtin_amdgcn_logf(l); }
#pragma unroll
    for (int d = 0; d < 64; d += 8) store_bf16x8(op + d, (f32x4){o[d] * il, o[d + 1] * il, o[d + 2] * il, o[d + 3] * il}, (f32x4){o[d + 4] * il, o[d + 5] * il, o[d + 6] * il, o[d + 7] * il});
}
__global__ void __launch_bounds__(256) combine_C(Params P) {
    const int t = blockIdx.x * 256 + threadIdx.x; if (t >= M * 32) return;
    const int row = t >> 5, i = (t >> 3) & 3, ch = t & 7;
    const float* lse = (const float*)(P.ws + WS_LSEC);
    const float l0 = lse[((size_t)0 * M + row) * 4 + i], l1 = lse[((size_t)1 * M + row) * 4 + i], l2 = lse[((size_t)2 * M + row) * 4 + i];
    const float mx = fmaxf(l0, fmaxf(l1, l2));
    float w0 = __builtin_amdgcn_exp2f(l0 - mx), w1 = __builtin_amdgcn_exp2f(l1 - mx), w2 = __builtin_amdgcn_exp2f(l2 - mx);
    const float inv = 1.0f / (w0 + w1 + w2); w0 *= inv; w1 *= inv; w2 *= inv;
    const bf16_t* cq = (const bf16_t*)(P.ws + WS_CQ) + (size_t)row * 768 + i * 64 + ch * 8;
    float a[8], bb[8], c[8]; unpack8(*(const u32x4*)cq, a); unpack8(*(const u32x4*)(cq + 256), bb); unpack8(*(const u32x4*)(cq + 512), c);
    float r[8];
#pragma unroll
    for (int e = 0; e < 8; ++e) r[e] = w0 * a[e] + w1 * bb[e] + w2 * c[e];
    store_bf16x8((bf16_t*)(P.ws + WS_AO1) + (size_t)row * 1024 + i * 64 + ch * 8, (f32x4){r[0], r[1], r[2], r[3]}, (f32x4){r[4], r[5], r[6], r[7]});
}
__global__ void __launch_bounds__(256) final_norm(Params P) {
    const int gw = (blockIdx.x * 256 + threadIdx.x) >> 6, lane = threadIdx.x & 63; if (gw >= M) return;
    const float r = rnorm_slots((const float*)(P.ws + WS_SSH) + (size_t)gw * 32, 32, 1.0f / 1024.0f);
    f32x4* h = (f32x4*)(P.out + (size_t)gw * DM) + lane; const f32x4* g = (const f32x4*)P.in[4] + lane;
#pragma unroll
    for (int j = 0; j < 4; ++j) h[64 * j] = h[64 * j] * r * g[64 * j];
}
__global__ void __launch_bounds__(256) prologue_kernel(Params P) {
    __shared__ float scr[4 * 64 * 33];
    const int wave = threadIdx.x >> 6, lane = threadIdx.x & 63;
    prologue_phase(P, scr + wave * 64 * 33, blockIdx.x * 4 + wave, gridDim.x * 4, lane);
}

namespace att {
#define LAS __attribute__((address_space(3)))
typedef short bf16x8 __attribute__((ext_vector_type(8)));
typedef short s16x4 __attribute__((ext_vector_type(4)));
typedef float f32x16 __attribute__((ext_vector_type(16)));
typedef float f32x2_t __attribute__((ext_vector_type(2)));
typedef __bf16 bf16x2_t __attribute__((ext_vector_type(2)));
constexpr int KBUF_BYTES = 12 * 1024, VBUF_BYTES = 16 * 1024;
constexpr int LDS_K = 0, LDS_V = 2 * KBUF_BYTES;
constexpr int LDS_RB = 8 * 32 * 132 * 4  , LDS_XCH = LDS_RB + 8448, LDS_TOTAL = LDS_XCH + 1024;
constexpr float THR = 12.0f;
enum { MODE_A = 0, MODE_D = 1, MODE_B = 2, MODE_C = 3 };
typedef LAS char* lds_ptr;

__device__ __forceinline__ int crow(int r, int hi) { return (r & 3) + 8 * (r >> 2) + 4 * hi; }
__device__ __forceinline__ unsigned cvtpk(float lo, float hi) { f32x2_t v = {lo, hi}; bf16x2_t b = __builtin_convertvector(v, bf16x2_t); return __builtin_bit_cast(unsigned, b); }
__device__ __forceinline__ s16x4 vtr(LAS const char* p) { typedef short v4i16_t __attribute__((ext_vector_type(4))); return __builtin_bit_cast(s16x4, __builtin_amdgcn_ds_read_tr16_b64_v4i16((LAS v4i16_t*)p)); }
__device__ __forceinline__ void glds16(const void* src, LAS char* dst) { unsigned keep; const unsigned d = (unsigned)__builtin_amdgcn_readfirstlane((int)(unsigned)(__UINTPTR_TYPE__)dst);
    asm volatile("s_mov_b32 %0, m0\n\ts_mov_b32 m0, %2\n\ts_nop 0\n\tglobal_load_lds_dwordx4 %1, off\n\ts_mov_b32 m0, %0" : "=&s"(keep) : "v"(src), "s"(d) : "memory"); }
#define ATT_DMA_WAIT() asm volatile("s_waitcnt vmcnt(0)" ::: "memory")
__device__ __forceinline__ float xhalf_sum(float v) { auto rr = __builtin_amdgcn_permlane32_swap(__float_as_uint(v), __float_as_uint(v), false, false); return __uint_as_float(rr[0]) + __uint_as_float(rr[1]); }
__device__ __forceinline__ float xhalf_max(float v) { auto rr = __builtin_amdgcn_permlane32_swap(__float_as_uint(v), __float_as_uint(v), false, false); return fmaxf(__uint_as_float(rr[0]), __uint_as_float(rr[1])); }

struct UnitDesc {
    const bf16_t* q; long qstride;
    const bf16_t* k; long kstride;
    const bf16_t* k2; long k2stride;
    const bf16_t* v; long vstride;
    int L, j0, nt;
    int dil, W, TW;
};

template <int DQK, int DV, int MODE>
__device__ __forceinline__ void attn_core(LAS char* lds, const UnitDesc& U, int qrow0, int qj0, int tlo, int thi, LAS const float* rbw, f32x16 (&o)[DV / 32], float& m, float& l) {
    const int tid = threadIdx.x, lane = tid & 63, r32 = lane & 31, hi = lane >> 5;
    const int wid = __builtin_amdgcn_readfirstlane(tid >> 6);
    constexpr int NKS = DQK / 16, ND0 = DV / 32;
    LAS float* xch = (LAS float*)(lds + LDS_XCH) + wid * 32;
    bf16x8 qf[NKS];
    {
        const bf16_t* qp = U.q + (long)(qrow0 + r32) * U.qstride + 8 * hi;
#pragma unroll
        for (int ks = 0; ks < NKS; ++ks) qf[ks] = *(const bf16x8*)(qp + 16 * ks);
        if (MODE != MODE_B) {
            const int jq = qj0 + r32; float a = 0.f;
            const bf16_t* kp = U.k + (long)jq * U.kstride + 8 * hi; const bf16_t* kp2 = (DQK > 64) ? U.k2 + (long)jq * U.k2stride + 8 * hi : nullptr;
#pragma unroll
            for (int ks = 0; ks < NKS; ++ks) { const u32x4 kw = (ks < 4) ? *(const u32x4*)(kp + 16 * ks) : *(const u32x4*)(kp2 + 16 * (ks - 4));
                const u32x4 qw = __builtin_bit_cast(u32x4, qf[ks]);
                a += bflo(kw.x) * bflo(qw.x) + bfhi(kw.x) * bfhi(qw.x) + bflo(kw.y) * bflo(qw.y) + bfhi(kw.y) * bfhi(qw.y)
                   + bflo(kw.z) * bflo(qw.z) + bfhi(kw.z) * bfhi(qw.z) + bflo(kw.w) * bflo(qw.w) + bfhi(kw.w) * bfhi(qw.w); }
            a = xhalf_sum(a);
            if (MODE != MODE_D) a += rbw[U.TW];
            m = a; l = 0.f;
        }
    }
#pragma unroll
    for (int d = 0; d < ND0; ++d) o[d] = f32x16{};
    auto issue = [&](int t, int buf) {
        const int jt0 = U.j0 + 64 * t;
        {   int j = jt0 + lane; j = j < 0 ? 0 : (j >= U.L ? U.L - 1 : j);
            glds16(U.k + (long)j * U.kstride + wid * 8, lds + LDS_K + buf * KBUF_BYTES + wid * 1024);
            if (DQK > 64) { if (wid < 4) glds16(U.k2 + (long)j * U.k2stride + wid * 8, lds + LDS_K + buf * KBUF_BYTES + (8 + wid) * 1024); } }
#pragma unroll
        for (int i = 0; i < ND0 / 2; ++i) { const int d0 = (wid >> 2) + 2 * i, kg = wid & 3;
            int j = jt0 + 16 * kg + (lane >> 2); j = j < 0 ? 0 : (j >= U.L ? U.L - 1 : j);
            glds16(U.v + (long)j * U.vstride + d0 * 32 + (lane & 3) * 8, lds + LDS_V + buf * VBUF_BYTES + d0 * 4096 + kg * 1024); }
    };
    issue(0, 0);
    ATT_DMA_WAIT(); __syncthreads();
    for (int t = 0; t < U.nt; ++t) {
        const int buf = t & 1;
        if (t + 1 < U.nt) issue(t + 1, buf ^ 1);
        if (t >= tlo && t <= thi) {
            const int jt0 = U.j0 + 64 * t;
            f32x16 p0, p1; bool near = true; float init = -m;
            if (MODE == MODE_A) { const int maxrel = jt0 + 63 - qj0, minrel = jt0 - (qj0 + 31);
                if (maxrel <= -559) { near = false; init = rbw[0] - m; } else if (minrel >= 559) { near = false; init = rbw[2 * U.TW] - m; } }
#pragma unroll
            for (int r = 0; r < 16; ++r) { p0[r] = init; p1[r] = init; }
            LAS const char* kb = lds + LDS_K + buf * KBUF_BYTES + hi * 1024 + r32 * 16;
#pragma unroll
            for (int ks = 0; ks < NKS; ++ks) { const bf16x8 k0 = *(LAS const bf16x8*)(kb + ks * 2048), k1 = *(LAS const bf16x8*)(kb + ks * 2048 + 512);
                p0 = __builtin_amdgcn_mfma_f32_32x32x16_bf16(k0, qf[ks], p0, 0, 0, 0); p1 = __builtin_amdgcn_mfma_f32_32x32x16_bf16(k1, qf[ks], p1, 0, 0, 0); }
            if (MODE != MODE_D) {
                const int relb = jt0 + 4 * hi - (qj0 + r32);
                if (MODE == MODE_A) { if (near) { LAS const float* rb = rbw + (relb + U.TW);
#pragma unroll
                        for (int r = 0; r < 16; ++r) { const int off = (r & 3) + 8 * (r >> 2); p0[r] += rb[off]; p1[r] += rb[off + 32]; } } }
                else { const int W = U.W, TW = U.TW, jq = qj0 + r32;
#pragma unroll
                    for (int r = 0; r < 16; ++r) {
#pragma unroll
                        for (int ph = 0; ph < 2; ++ph) { const int rel = relb + 32 * ph + (r & 3) + 8 * (r >> 2); const int rc = rel < -TW ? -TW : (rel > TW ? TW : rel);
                            const float bv = rbw[rc + TW]; const bool ok = ((unsigned)(rel + W) <= (unsigned)(2 * W)) && ((unsigned)(jq + rel) < (unsigned)U.L);
                            if (ph == 0) p0[r] = ok ? p0[r] + bv : -1e30f; else p1[r] = ok ? p1[r] + bv : -1e30f; } } }
            }
            float mt = fmaxf(p0[0], p1[0]);
#pragma unroll
            for (int r = 1; r < 16; ++r) mt = fmaxf(mt, fmaxf(p0[r], p1[r]));
            mt = xhalf_max(mt);
            if (__any(mt > THR)) {
                const float dl = fmaxf(mt, 0.f), f = __builtin_amdgcn_exp2f(-dl);
                m += dl; l *= f;
#pragma unroll
                for (int r = 0; r < 16; ++r) { p0[r] -= dl; p1[r] -= dl; }
                if (hi == 0) xch[r32] = f;
#pragma unroll
                for (int g4 = 0; g4 < 4; ++g4) { const f32x4 f4 = *(LAS const f32x4*)(xch + 8 * g4 + 4 * hi);
#pragma unroll
                    for (int d = 0; d < ND0; ++d) { o[d][4 * g4] *= f4.x; o[d][4 * g4 + 1] *= f4.y; o[d][4 * g4 + 2] *= f4.z; o[d][4 * g4 + 3] *= f4.w; } }
            }
            float rs = 0.f;
#pragma unroll
            for (int r = 0; r < 16; ++r) { p0[r] = __builtin_amdgcn_exp2f(p0[r]); p1[r] = __builtin_amdgcn_exp2f(p1[r]); rs += p0[r] + p1[r]; }
            l += rs;
            bf16x8 pa[4];
            { u32x4 w;
              w.x = cvtpk(p0[0], p0[1]); w.y = cvtpk(p0[2], p0[3]); w.z = cvtpk(p0[4], p0[5]); w.w = cvtpk(p0[6], p0[7]); pa[0] = __builtin_bit_cast(bf16x8, w);
              w.x = cvtpk(p0[8], p0[9]); w.y = cvtpk(p0[10], p0[11]); w.z = cvtpk(p0[12], p0[13]); w.w = cvtpk(p0[14], p0[15]); pa[1] = __builtin_bit_cast(bf16x8, w);
              w.x = cvtpk(p1[0], p1[1]); w.y = cvtpk(p1[2], p1[3]); w.z = cvtpk(p1[4], p1[5]); w.w = cvtpk(p1[6], p1[7]); pa[2] = __builtin_bit_cast(bf16x8, w);
              w.x = cvtpk(p1[8], p1[9]); w.y = cvtpk(p1[10], p1[11]); w.z = cvtpk(p1[12], p1[13]); w.w = cvtpk(p1[14], p1[15]); pa[3] = __builtin_bit_cast(bf16x8, w); }
            LAS const char* vb = lds + LDS_V + buf * VBUF_BYTES + ((lane >> 4) & 1) * 32 + (lane & 3) * 8 + (4 * hi + ((lane & 15) >> 2)) * 64;
#pragma unroll
            for (int d = 0; d < ND0; ++d)
#pragma unroll
                for (int ks = 0; ks < 4; ++ks) { const s16x4 lo = vtr(vb + d * 4096 + ks * 1024), hh = vtr(vb + d * 4096 + ks * 1024 + 512);
                    const bf16x8 vf = {lo[0], lo[1], lo[2], lo[3], hh[0], hh[1], hh[2], hh[3]};
                    o[d] = __builtin_amdgcn_mfma_f32_32x32x16_bf16(pa[ks], vf, o[d], 0, 0, 0); }
        }
        ATT_DMA_WAIT(); __syncthreads();
    }
    l = xhalf_sum(l);
}
template <int DV>
__device__ __forceinline__ LAS float* stage_o(LAS char* lds, const f32x16 (&o)[DV / 32], float l) {
    const int lane = threadIdx.x & 63, r32 = lane & 31, hi = lane >> 5; const int wid = __builtin_amdgcn_readfirstlane(threadIdx.x >> 6);
    LAS float* xch = (LAS float*)(lds + LDS_XCH) + wid * 32;
    LAS float* st = (LAS float*)lds + wid * 32 * (DV + 4);
    if (hi == 0) xch[r32] = 1.0f / l;
#pragma unroll
    for (int g4 = 0; g4 < 4; ++g4) { const f32x4 f4 = *(LAS const f32x4*)(xch + 8 * g4 + 4 * hi);
#pragma unroll
        for (int i = 0; i < 4; ++i) { const int r = 4 * g4 + i; const float il = i == 0 ? f4.x : (i == 1 ? f4.y : (i == 2 ? f4.z : f4.w));
#pragma unroll
            for (int d = 0; d < DV / 32; ++d) st[crow(r, hi) * (DV + 4) + d * 32 + r32] = o[d][r] * il; } }
    return st + (lane >> 1) * (DV + 4) + (lane & 1) * (DV / 2);
}
}

__device__ __forceinline__ void attn_unit_D(att::lds_ptr lds, unsigned char* ws, int b, int h, int qb) {
    using namespace att;
    const int lane = threadIdx.x & 63; const int wid = __builtin_amdgcn_readfirstlane(threadIdx.x >> 6);
    const size_t row0 = (size_t)b * SEQ;
    UnitDesc U;
    U.q = (const bf16_t*)(ws + WS_QD) + (row0 + qb * 256) * 1152 + h * 96; U.qstride = 1152;
    U.k = (const bf16_t*)(ws + WS_KD) + row0 * 768 + h * 64; U.kstride = 768;
    U.k2 = (const bf16_t*)(ws + WS_KPE) + row0 * 32; U.k2stride = 32;
    U.v = (const bf16_t*)(ws + WS_VD) + row0 * 768 + h * 64; U.vstride = 768;
    U.L = SEQ; U.j0 = 0; U.nt = SEQ / 64; U.dil = 1; U.W = 0; U.TW = 0;
    f32x16 o[2]; float m = 0.f, l = 0.f;
    attn_core<96, 64, MODE_D>(lds, U, wid * 32, qb * 256 + wid * 32, 0, U.nt - 1, (LAS const float*)(lds + LDS_RB), o, m, l);
    LAS float* sp = stage_o<64>(lds, o, l);
    bf16_t* op = (bf16_t*)(ws + WS_AO1) + (row0 + qb * 256 + wid * 32 + (lane >> 1)) * 1024 + 256 + h * 64 + (lane & 1) * 32;
#pragma unroll
    for (int i = 0; i < 4; ++i) { const f32x4 a = *(LAS const f32x4*)(sp + 8 * i), c = *(LAS const f32x4*)(sp + 8 * i + 4); store_bf16x8(op + 8 * i, a, c); }
    __syncthreads();
}
constexpr int ATT_LDS_BYTES = att::LDS_TOTAL;
__global__ void __launch_bounds__(512, 2) attn_D_kernel(Params P) {
    extern __shared__ __attribute__((aligned(16))) unsigned char dynlds[];
    att::lds_ptr lds = (att::lds_ptr)dynlds;
    for (int u = blockIdx.x; u < 768; u += gridDim.x) { const int c = u % 256, i = u / 256; const int bh = (c % 8) + 8 * i, qb = c / 8; attn_unit_D(lds, P.ws, bh / 12, bh % 12, qb); }
}

__device__ __forceinline__ void attn_unit_A(att::lds_ptr lds, const Params& P, int b, int h, int qb) {
    using namespace att;
    unsigned char* ws = P.ws;
    const int tid = threadIdx.x, lane = tid & 63; const int wid = __builtin_amdgcn_readfirstlane(tid >> 6);
    const size_t row0 = (size_t)b * SEQ;
    LAS float* rbs = (LAS float*)(lds + LDS_RB);
    { const float* rbg = (const float*)(ws + WS_RB) + h * RBW; for (int i = tid; i < RBW; i += 512) rbs[i] = rbg[i]; }
    __syncthreads();
    const bf16_t* P0 = (const bf16_t*)(ws + WS_P0);
    UnitDesc U;
    U.qstride = 2304; U.kstride = 2304; U.k2 = nullptr; U.k2stride = 0; U.vstride = 2304;
    U.v = P0 + row0 * 2304 + 1024 + h * 128;
    U.L = SEQ; U.j0 = 0; U.nt = SEQ / 64; U.dil = 1; U.W = 0; U.TW = 1024;
    const size_t orow = row0 + qb * 256 + wid * 32 + (lane >> 1);
    float* o1p = P.out + orow * 512 + h * 128 + (lane & 1) * 64;
#pragma unroll 1
    for (int sm = 0; sm < 2; ++sm) {
        U.q = P0 + (row0 + qb * 256) * 2304 + h * 128 + sm * 64;
        U.k = P0 + row0 * 2304 + 512 + h * 128 + sm * 64;
        f32x16 o[4]; float m = 0.f, l = 0.f;
        attn_core<64, 128, MODE_A>(lds, U, wid * 32, qb * 256 + wid * 32, 0, U.nt - 1, rbs, o, m, l);
        LAS float* sp = stage_o<128>(lds, o, l);
        if (sm == 0) {
#pragma unroll
            for (int i = 0; i < 16; ++i) *(f32x4*)(o1p + 4 * i) = *(LAS const f32x4*)(sp + 4 * i);
        } else {
            const float lam = ((const float*)(ws + WS_MISCF))[0];
            f32x4 x[16]; float ss = 0.f;
#pragma unroll
            for (int i = 0; i < 16; ++i) { const f32x4 a = *(const f32x4*)(o1p + 4 * i), c = *(LAS const f32x4*)(sp + 4 * i); x[i] = a - c * lam;
                ss += (x[i].x * x[i].x + x[i].y * x[i].y) + (x[i].z * x[i].z + x[i].w * x[i].w); }
            ss += __shfl_xor(ss, 1);
            const float r = 0.8f / sqrtf(ss * (1.0f / 128.0f) + EPS);
            const f32x4* g = (const f32x4*)(P.in[10] + (lane & 1) * 64);
            bf16_t* op = (bf16_t*)(ws + WS_AO0) + orow * 1024 + h * 128 + (lane & 1) * 64;
#pragma unroll
            for (int i = 0; i < 8; ++i) store_bf16x8(op + 8 * i, x[2 * i] * g[2 * i] * r, x[2 * i + 1] * g[2 * i + 1] * r);
        }
        __syncthreads();
    }
}
__device__ __forceinline__ void attn_unit_B(att::lds_ptr lds, const Params& P, int b, int g, int qblk) {
    using namespace att;
    unsigned char* ws = P.ws;
    const int tid = threadIdx.x, lane = tid & 63; const int wid = __builtin_amdgcn_readfirstlane(tid >> 6);
    const size_t row0 = (size_t)b * SEQ; const int q0 = qblk * 64, hl = wid >> 1, hq = 4 * g + hl;
    LAS float* rbs = (LAS float*)(lds + LDS_RB);
    { const float* rbg = (const float*)(ws + WS_RB); for (int i = tid; i < 4 * 385; i += 512) { const int h4 = i / 385, j = i % 385; rbs[i] = rbg[(4 + 4 * g + h4) * RBW + (j - 192) + 1024]; } }
    __syncthreads();
    const bf16_t* P0 = (const bf16_t*)(ws + WS_P0);
    UnitDesc U;
    U.q = P0 + (row0 + q0) * 2304 + 1536 + hq * 64; U.qstride = 2304;
    U.k = P0 + row0 * 2304 + 2048 + g * 64; U.kstride = 2304; U.k2 = nullptr; U.k2stride = 0;
    U.v = P0 + row0 * 2304 + 2176 + g * 64; U.vstride = 2304;
    U.L = SEQ; U.j0 = q0 - 128; U.nt = 5; U.dil = 1; U.W = 128; U.TW = 192;
    f32x16 o[2]; float m = P.in[11][hq] * LOG2E, l = (lane < 32) ? 1.0f : 0.0f;
    attn_core<64, 64, MODE_B>(lds, U, 32 * (wid & 1), q0 + 32 * (wid & 1), 0, 4, rbs + hl * 385, o, m, l);
    LAS float* sp = stage_o<64>(lds, o, l);
    bf16_t* op = (bf16_t*)(ws + WS_AO0) + (row0 + q0 + 32 * (wid & 1) + (lane >> 1)) * 1024 + 512 + hq * 64 + (lane & 1) * 32;
#pragma unroll
    for (int i = 0; i < 4; ++i) { const f32x4 a = *(LAS const f32x4*)(sp + 8 * i), c = *(LAS const f32x4*)(sp + 8 * i + 4); store_bf16x8(op + 8 * i, a, c); }
    __syncthreads();
}
__device__ __forceinline__ void attn_unit_C(att::lds_ptr lds, const Params& P, int b, int hh, int res, int sblk) {
    using namespace att;
    unsigned char* ws = P.ws;
    const int tid = threadIdx.x, lane = tid & 63; const int wid = __builtin_amdgcn_readfirstlane(tid >> 6);
    const int grp = hh >> 2, dil = (grp == 0) ? 1 : (grp == 1 ? 4 : 16);
    const size_t row0 = (size_t)b * SEQ + res;
    LAS float* rbs = (LAS float*)(lds + LDS_RB);
    { const float* rbg = (const float*)(ws + WS_RB) + hh * RBW; for (int i = tid; i < 129; i += 512) rbs[i] = rbg[(i - 64) * dil + 1024]; }
    __syncthreads();
    UnitDesc U;
    U.q = (const bf16_t*)(ws + WS_CQ) + row0 * 768 + hh * 64; U.qstride = 768 * dil;
    U.k = (const bf16_t*)(ws + WS_CK) + row0 * 768 + hh * 64; U.kstride = 768 * dil; U.k2 = nullptr; U.k2stride = 0;
    U.v = (const bf16_t*)(ws + WS_CV) + row0 * 768 + hh * 64; U.vstride = 768 * dil;
    U.L = SEQ / dil; U.j0 = sblk * 256 - 64; U.nt = 6; U.dil = dil; U.W = 64; U.TW = 64;
    const int qj0 = sblk * 256 + 32 * wid;
    f32x16 o[2]; float m = 0.f, l = 0.f;
    attn_core<64, 64, MODE_C>(lds, U, qj0, qj0, wid >> 1, (wid >> 1) + 2, rbs, o, m, l);
    if (lane < 32) ((float*)(ws + WS_LSEC))[((size_t)grp * M + row0 + (size_t)dil * (qj0 + lane)) * 4 + (hh & 3)] = m + __builtin_amdgcn_logf(l);
    LAS float* sp = stage_o<64>(lds, o, l);
    bf16_t* op = (bf16_t*)(ws + WS_CQ) + (row0 + (size_t)dil * (qj0 + (lane >> 1))) * 768 + hh * 64 + (lane & 1) * 32;
#pragma unroll
    for (int i = 0; i < 4; ++i) { const f32x4 a = *(LAS const f32x4*)(sp + 8 * i), c = *(LAS const f32x4*)(sp + 8 * i + 4); store_bf16x8(op + 8 * i, a, c); }
    __syncthreads();
}
__global__ void __launch_bounds__(512, 2) attn_AB_kernel(Params P) {
    extern __shared__ __attribute__((aligned(16))) unsigned char dynlds[];
    att::lds_ptr lds = (att::lds_ptr)dynlds;
    for (int u = blockIdx.x; u < 256; u += gridDim.x) { const int bh = u % 8, qb = u / 8; attn_unit_A(lds, P, bh >> 2, bh & 3, qb); }
    for (int u = blockIdx.x; u < 512; u += gridDim.x) { const int bg = u & 3, qblk = u >> 2; attn_unit_B(lds, P, bg >> 1, bg & 1, qblk); }
}
__global__ void __launch_bounds__(512, 2) attn_C_kernel(Params P) {
    extern __shared__ __attribute__((aligned(16))) unsigned char dynlds[];
    att::lds_ptr lds = (att::lds_ptr)dynlds;
    for (int u = blockIdx.x; u < 768; u += gridDim.x) { const int hh = u >> 6, idx = u & 63, b = idx >> 5, t = idx & 31;
        const int grp = hh >> 2, dil = (grp == 0) ? 1 : (grp == 1 ? 4 : 16), nblk = 32 / dil;
        attn_unit_C(lds, P, b, hh, t / nblk, t % nblk); }
}

extern "C" void kernel_launch(void* const* d_in, const int* in_sizes, int n_in, void* d_out, int out_size, void* d_ws, size_t ws_size, hipStream_t stream) {
    Params P{};
    for (int i = 0; i < 22; ++i) P.in[i] = (const float*)d_in[i];
    P.out = (float*)d_out; P.ws = (unsigned char*)d_ws;
    unsigned char* ws = P.ws;
    bf16_t* W = (bf16_t*)(ws + WS_W); bf16_t* HB = (bf16_t*)(ws + WS_HB);
    float* ssh = (float*)(ws + WS_SSH); float* ssl = (float*)(ws + WS_SSL); const float* rope = (const float*)(ws + WS_ROPE);
    static bool attr_done = false;
    if (!attr_done) {
        hipFuncSetAttribute((const void*)gemm_kernel<EpiProj0>, hipFuncAttributeMaxDynamicSharedMemorySize, GEMM_LDS_BYTES);
        hipFuncSetAttribute((const void*)gemm_kernel<EpiResid>, hipFuncAttributeMaxDynamicSharedMemorySize, GEMM_LDS_BYTES);
        hipFuncSetAttribute((const void*)gemm_kernel<EpiSwiGLU>, hipFuncAttributeMaxDynamicSharedMemorySize, GEMM_LDS_BYTES);
        hipFuncSetAttribute((const void*)gemm_kernel<EpiProj1>, hipFuncAttributeMaxDynamicSharedMemorySize, GEMM_LDS_BYTES);
        hipFuncSetAttribute((const void*)gemm_kernel<EpiQb>, hipFuncAttributeMaxDynamicSharedMemorySize, GEMM_LDS_BYTES);
        hipFuncSetAttribute((const void*)gemm_kernel<EpiKVb>, hipFuncAttributeMaxDynamicSharedMemorySize, GEMM_LDS_BYTES);
        hipFuncSetAttribute((const void*)attn_D_kernel, hipFuncAttributeMaxDynamicSharedMemorySize, ATT_LDS_BYTES);
        hipFuncSetAttribute((const void*)attn_AB_kernel, hipFuncAttributeMaxDynamicSharedMemorySize, ATT_LDS_BYTES);
        hipFuncSetAttribute((const void*)attn_C_kernel, hipFuncAttributeMaxDynamicSharedMemorySize, ATT_LDS_BYTES);
        attr_done = true;
    }
    prologue_kernel<<<1024, 256, 0, stream>>>(P);
    { EpiProj0 E{ssh, (bf16_t*)(ws + WS_P0)}; gemm_kernel<EpiProj0><<<256, 512, GEMM_LDS_BYTES, stream>>>(HB, 1024, W + WO_ABIN, 2304, 1024, E); }
    attn_AB_kernel<<<256, 512, ATT_LDS_BYTES, stream>>>(P);
    { EpiResid E{P.in[0], P.out, HB, ssh}; gemm_kernel<EpiResid><<<256, 512, GEMM_LDS_BYTES, stream>>>((bf16_t*)(ws + WS_AO0), 1024, W + WO_ABO, 1024, 1024, E); }
    { EpiSwiGLU E{ssh, (bf16_t*)(ws + WS_ACT)}; gemm_kernel<EpiSwiGLU><<<256, 512, GEMM_LDS_BYTES, stream>>>(HB, 1024, W + WO_GU, 5632, 1024, E); }
    { EpiResid E{P.out, P.out, HB, ssh}; gemm_kernel<EpiResid><<<256, 512, GEMM_LDS_BYTES, stream>>>((bf16_t*)(ws + WS_ACT), 2816, W + WO_DN, 1024, 2816, E); }
    { EpiProj1 E{ssh, ssl, rope, (bf16_t*)(ws + WS_CQ), (bf16_t*)(ws + WS_CK), (bf16_t*)(ws + WS_CV), (bf16_t*)(ws + WS_LAT), (bf16_t*)(ws + WS_KPE)};
      gemm_kernel<EpiProj1><<<256, 512, GEMM_LDS_BYTES, stream>>>(HB, 1024, W + WO_CDIN, 3072, 1024, E); }
    { EpiQb E{ssl, rope, (bf16_t*)(ws + WS_QD)}; gemm_kernel<EpiQb><<<256, 512, GEMM_LDS_BYTES, stream>>>((bf16_t*)(ws + WS_LAT), 768, W + WO_QB, 1280, 384, E); }
    { EpiKVb E{ssl, (bf16_t*)(ws + WS_KD), (bf16_t*)(ws + WS_VD)}; gemm_kernel<EpiKVb><<<256, 512, GEMM_LDS_BYTES, stream>>>((bf16_t*)(ws + WS_LAT) + 384, 768, W + WO_KVB, 1536, 256, E); }
    attn_C_kernel<<<256, 512, ATT_LDS_BYTES, stream>>>(P);
    combine_C<<<M * 32 / 256, 256, 0, stream>>>(P);
    attn_D_kernel<<<256, 512, ATT_LDS_BYTES, stream>>>(P);
    { EpiResid E{P.out, P.out, HB, ssh}; gemm_kernel<EpiResid><<<256, 512, GEMM_LDS_BYTES, stream>>>((bf16_t*)(ws + WS_AO1), 1024, W + WO_CDO, 1024, 1024, E); }
    { EpiSwiGLU E{ssh, (bf16_t*)(ws + WS_ACT)}; gemm_kernel<EpiSwiGLU><<<256, 512, GEMM_LDS_BYTES, stream>>>(HB, 1024, W + WO_GU + (size_t)5632 * 1024, 5632, 1024, E); }
    { EpiResid E{P.out, P.out, HB, ssh}; gemm_kernel<EpiResid><<<256, 512, GEMM_LDS_BYTES, stream>>>((bf16_t*)(ws + WS_ACT), 2816, W + WO_DN + (size_t)1024 * 2816, 1024, 2816, E); }
    final_norm<<<M * 64 / 256, 256, 0, stream>>>(P);
}
```
